# Optimizing an MI355X kernel written in HIP

```python
import math
import jax, jax.numpy as jnp
from jax import lax
import numpy as np

D_MODEL = 2048
BATCH = 4
SEQ = 2048
DEPTH = 4

MEM_LEN = 256
EPS = 1e-6
POOL_DIM = D_MODEL // 2
POOL_WINDOWS = (2, 4, 8, 16)
POOL_GROUPS = len(POOL_WINDOWS)
POOL_GROUP_DIM = POOL_DIM // POOL_GROUPS
HGRN_DIM = D_MODEL // 2
HGRN_EXPAND = 128
HGRN_HEADS = HGRN_DIM // HGRN_EXPAND
HGRN_KEY_DIM = HGRN_EXPAND
HGRN_VAL_DIM = HGRN_DIM // HGRN_HEADS
FORGET_DIM = HGRN_HEADS * HGRN_KEY_DIM
CHUNK = 64
X_HEADS = 4
X_HEAD_DIM = D_MODEL // X_HEADS
D_FF = -(-(8 * D_MODEL) // (3 * 256)) * 256
IN_COLS = POOL_DIM + 2 * FORGET_DIM + 2 * HGRN_DIM + 2 * D_MODEL
IN_SPLITS = (
    POOL_DIM,
    POOL_DIM + FORGET_DIM,
    POOL_DIM + 2 * FORGET_DIM,
    POOL_DIM + 2 * FORGET_DIM + HGRN_DIM,
    POOL_DIM + 2 * FORGET_DIM + 2 * HGRN_DIM,
    POOL_DIM + 2 * FORGET_DIM + 2 * HGRN_DIM + D_MODEL,
)

kernel_name = "hybrid_pool_hgrn2_gated_xattn_swiglu"


def rmsnorm(x, gain):
    x32 = x.astype(jnp.float32)
    y = x32 * lax.rsqrt(jnp.mean(x32 * x32, axis=-1, keepdims=True) + EPS)
    return (y * gain.astype(jnp.float32)).astype(x.dtype)


def causal_multiscale_pool(a, w_group, scale):
    B_, S_, _ = a.shape
    a32 = a.astype(jnp.float32)
    csum = jnp.pad(jnp.cumsum(a32, axis=1), ((0, 0), (1, 0), (0, 0)))
    t = np.arange(S_)
    outs = []
    for g, w in enumerate(POOL_WINDOWS):
        lo, hi = g * POOL_GROUP_DIM, (g + 1) * POOL_GROUP_DIM
        c = csum[..., lo:hi]
        start = np.maximum(t + 1 - w, 0)
        count = jnp.asarray(np.minimum(t + 1, w).astype(np.float32))[None, :, None]
        window_mean = (c[:, 1:] - c[:, start]) / count
        outs.append(window_mean - a32[..., lo:hi])
    pooled = jnp.stack(outs, axis=2).astype(a.dtype)
    mixed = jnp.einsum('bsgc,gcd->bsgd', pooled, w_group)
    return mixed.reshape(B_, S_, POOL_DIM) * scale


def hgrn2_chunked(q, k, v, log_f):
    B_, S_, H, K = q.shape
    V = v.shape[-1]
    nc = S_ // CHUNK

    def to_chunks(z):
        return z.reshape(B_, nc, CHUNK, H, z.shape[-1]).transpose(1, 0, 3, 2, 4)

    qc, kc, vc, gc = to_chunks(q), to_chunks(k), to_chunks(v), to_chunks(log_f)
    causal = jnp.tril(jnp.ones((CHUNK, CHUNK), dtype=bool))

    def step(state, inp):
        q_, k_, v_, g_ = inp
        b = jnp.cumsum(g_, axis=2)
        rel = b[:, :, :, None, :] - b[:, :, None, :, :]
        decay = jnp.exp(jnp.where(causal[:, :, None], rel, -jnp.inf))
        scores = jnp.einsum('bhtsk,bhsk->bhts', decay * q_[:, :, :, None, :], k_)
        o_intra = jnp.einsum('bhts,bhsv->bhtv', scores, v_)
        o_inter = jnp.einsum('bhtk,bhkv->bhtv', q_ * jnp.exp(b), state)
        b_last = b[:, :, -1:, :]
        k_dec = k_ * jnp.exp(b_last - b)
        new_state = state * jnp.exp(b_last[:, :, 0, :])[..., None] \
            + jnp.einsum('bhsk,bhsv->bhkv', k_dec, v_)
        return new_state, o_intra + o_inter

    state0 = jnp.zeros((B_, H, K, V), jnp.float32)
    _, o = lax.scan(step, state0, (qc, kc, vc, gc))
    return o.transpose(1, 0, 3, 2, 4).reshape(B_, S_, H, V)


def hgrn2_branch(z_q, z_f, z_i, z_og, lb, norm_gain):
    B_, S_, _ = z_q.shape
    dt = z_i.dtype
    zf = z_f.astype(jnp.float32)
    lb = lb.astype(jnp.float32)
    q = jax.nn.silu(z_q.astype(jnp.float32))
    log_f = jnp.logaddexp(jnp.log(lb), jnp.log1p(-lb) + jax.nn.log_sigmoid(zf))
    k = (1.0 - lb) * jax.nn.sigmoid(-zf)
    shp_k = (B_, S_, HGRN_HEADS, HGRN_KEY_DIM)
    o = hgrn2_chunked(q.reshape(shp_k), k.reshape(shp_k),
                      z_i.astype(jnp.float32).reshape(B_, S_, HGRN_HEADS, HGRN_VAL_DIM),
                      log_f.reshape(shp_k))
    o = o * lax.rsqrt(jnp.mean(o * o, axis=-1, keepdims=True) + EPS)
    o = o.reshape(B_, S_, HGRN_DIM) * norm_gain.astype(jnp.float32)
    return (o * jax.nn.silu(z_og.astype(jnp.float32))).astype(dt)


def memory_cross_attention(h, mem_n, w_q, w_kv, w_o):
    B_, S_, _ = h.shape
    M_ = mem_n.shape[1]
    q = (h @ w_q).reshape(B_, S_, X_HEADS, X_HEAD_DIM)
    k, v = jnp.split(mem_n @ w_kv, 2, axis=-1)
    k = k.reshape(B_, M_, X_HEADS, X_HEAD_DIM)
    v = v.reshape(B_, M_, X_HEADS, X_HEAD_DIM)
    s = jnp.einsum('bshd,bmhd->bhsm', q, k).astype(jnp.float32) * (X_HEAD_DIM ** -0.5)
    p = jax.nn.softmax(s, axis=-1).astype(h.dtype)
    o = jnp.einsum('bhsm,bmhd->bshd', p, v).reshape(B_, S_, D_MODEL)
    return o @ w_o


def swiglu(h, w_in, w_out):
    g, u = jnp.split(h @ w_in, 2, axis=-1)
    return (jax.nn.silu(g) * u) @ w_out


def setup_inputs(seed: int = 0) -> dict:
    key = jax.random.key(seed)
    ks = jax.random.split(key, 24)
    f32 = jnp.float32

    def nrm(k, shape, fan_in):
        return jax.random.normal(k, shape, f32) * (fan_in ** -0.5)

    def gain(k, shape):
        return 1.0 + 0.02 * jax.random.normal(k, shape, f32)

    return {
        "x": jax.random.normal(ks[0], (BATCH, SEQ, D_MODEL), f32),
        "mem": jax.random.normal(ks[1], (BATCH, MEM_LEN, D_MODEL), f32),
        "w_in": nrm(ks[2], (DEPTH, D_MODEL, IN_COLS), D_MODEL),
        "w_pool_group": nrm(ks[3], (DEPTH, POOL_GROUPS, POOL_GROUP_DIM, POOL_GROUP_DIM), POOL_GROUP_DIM),
        "pool_scale": gain(ks[4], (DEPTH, POOL_DIM)),
        "hgrn_lower_bounds": 0.1 * jax.random.normal(ks[5], (DEPTH, FORGET_DIM), f32),
        "hgrn_norm": gain(ks[6], (DEPTH, HGRN_DIM)),
        "w_branch_pool": nrm(ks[7], (DEPTH, POOL_DIM, D_MODEL), POOL_DIM),
        "w_branch_hgrn": nrm(ks[8], (DEPTH, HGRN_DIM, D_MODEL), HGRN_DIM),
        "w_mix_out": nrm(ks[9], (DEPTH, D_MODEL, D_MODEL), D_MODEL),
        "norm_mix": gain(ks[10], (DEPTH, D_MODEL)),
        "norm_mem": gain(ks[11], (DEPTH, D_MODEL)),
        "norm_cross": gain(ks[12], (DEPTH, D_MODEL)),
        "w_xq": nrm(ks[13], (DEPTH, D_MODEL, D_MODEL), D_MODEL),
        "w_xkv": nrm(ks[14], (DEPTH, D_MODEL, 2 * D_MODEL), D_MODEL),
        "w_xo": nrm(ks[15], (DEPTH, D_MODEL, D_MODEL), D_MODEL),
        "norm_ffn": gain(ks[16], (DEPTH, D_MODEL)),
        "w_ffn_in": nrm(ks[17], (DEPTH, D_MODEL, 2 * D_FF), D_MODEL),
        "w_ffn_out": nrm(ks[18], (DEPTH, D_FF, D_MODEL), D_FF),
        "norm_final": gain(ks[19], (D_MODEL,)),
    }


def reference(x, mem, w_in, w_pool_group, pool_scale, hgrn_lower_bounds, hgrn_norm,
              w_branch_pool, w_branch_hgrn, w_mix_out, norm_mix, norm_mem, norm_cross,
              w_xq, w_xkv, w_xo, norm_ffn, w_ffn_in, w_ffn_out, norm_final):
    lb_all = jnp.cumsum(jax.nn.softmax(hgrn_lower_bounds.astype(jnp.float32), axis=0), axis=0)
    lb_all = lb_all - lb_all[0:1]
    h = x
    for l in range(DEPTH):
        u = rmsnorm(h, norm_mix[l])
        z = u @ w_in[l]
        z_pool, z_q, z_f, z_i, z_og, z_ga, z_gb = jnp.split(z, IN_SPLITS, axis=-1)
        a_out = causal_multiscale_pool(z_pool, w_pool_group[l], pool_scale[l])
        b_out = hgrn2_branch(z_q, z_f, z_i, z_og, lb_all[l], hgrn_norm[l])
        merged = jax.nn.sigmoid(z_ga) * (a_out @ w_branch_pool[l]) \
            + jax.nn.sigmoid(z_gb) * (b_out @ w_branch_hgrn[l])
        h = h + merged @ w_mix_out[l]
        mem_n = rmsnorm(mem, norm_mem[l])
        h = h + memory_cross_attention(rmsnorm(h, norm_cross[l]), mem_n,
                                       w_xq[l], w_xkv[l], w_xo[l])
        h = h + swiglu(rmsnorm(h, norm_ffn[l]), w_ffn_in[l], w_ffn_out[l])
    return rmsnorm(h, norm_final)
```

```cpp
#include <hip/hip_runtime.h>
#include <cstdio>
#include <cstdint>

#ifndef MK_PER_PHASE
#define MK_PER_PHASE 0
#endif

#define LAS __attribute__((address_space(3)))
#define GAS __attribute__((address_space(1)))
typedef unsigned short bf16_t;
typedef short bf16x8 __attribute__((ext_vector_type(8)));
typedef float f32x4 __attribute__((ext_vector_type(4)));
typedef unsigned u32x4 __attribute__((ext_vector_type(4)));
typedef unsigned u32x2 __attribute__((ext_vector_type(2)));

constexpr int DM = 2048, NB = 4, SEQ = 2048, DEPTH = 4, MEML = 256;
constexpr int MROWS = NB * SEQ;
constexpr int MEMROWS = NB * MEML;
constexpr int PD = 1024, HDIM = 1024, XH = 4, XHD = 512, DFF = 5632, INC = 9216;
constexpr float EPS = 1e-6f;
constexpr float LOG2E = 1.4426950408889634f;

typedef __bf16 bf16x2_t __attribute__((ext_vector_type(2)));
typedef float f32x2_t __attribute__((ext_vector_type(2)));
__device__ __forceinline__ unsigned cvt_pk_bf16(float lo, float hi) { const f32x2_t v = {lo, hi}; const bf16x2_t r = __builtin_convertvector(v, bf16x2_t); return __builtin_bit_cast(unsigned, r); }
typedef _Float16 f16x2_t __attribute__((ext_vector_type(2)));
typedef _Float16 f16x8_t __attribute__((ext_vector_type(8)));
__device__ __forceinline__ unsigned cvt_pk_f16(float lo, float hi) { const f32x2_t v = {lo, hi}; const f16x2_t r = __builtin_convertvector(v, f16x2_t); return __builtin_bit_cast(unsigned, r); }
__device__ __forceinline__ float hf_lo(unsigned w) { return (float)__builtin_bit_cast(f16x2_t, w)[0]; }
__device__ __forceinline__ float hf_hi(unsigned w) { return (float)__builtin_bit_cast(f16x2_t, w)[1]; }
__device__ __forceinline__ float bf_lo(unsigned w) { return __uint_as_float(w << 16); }
__device__ __forceinline__ float bf_hi(unsigned w) { return __uint_as_float(w & 0xffff0000u); }
__device__ __forceinline__ float bf2f(bf16_t h) { return __uint_as_float(((unsigned)h) << 16); }
__device__ __forceinline__ bf16_t f2bf(float f) { return (bf16_t)(cvt_pk_bf16(f, 0.f) & 0xffffu); }
__device__ __forceinline__ float ex2(float x) { return __builtin_amdgcn_exp2f(x); }
__device__ __forceinline__ float rcpf_(float x) { return __builtin_amdgcn_rcpf(x); }
__device__ __forceinline__ float sigm(float z) { return rcpf_(1.0f + ex2(-z * LOG2E)); }
__device__ __forceinline__ void st_bf16x8(bf16_t* p, const f32x4 a, const f32x4 b) {
    u32x4 w; w.x = cvt_pk_bf16(a[0], a[1]); w.y = cvt_pk_bf16(a[2], a[3]); w.z = cvt_pk_bf16(b[0], b[1]); w.w = cvt_pk_bf16(b[2], b[3]);
    *(u32x4*)p = w;
}
__device__ __forceinline__ void st_f16x8(bf16_t* p, const f32x4 a, const f32x4 b) {
    u32x4 w; w.x = cvt_pk_f16(a[0], a[1]); w.y = cvt_pk_f16(a[2], a[3]); w.z = cvt_pk_f16(b[0], b[1]); w.w = cvt_pk_f16(b[2], b[3]);
    *(u32x4*)p = w;
}
__device__ __forceinline__ void ld_bf16x8(const bf16_t* p, f32x4& a, f32x4& b) {
    const u32x4 w = *(const u32x4*)p;
    a = (f32x4){bf_lo(w.x), bf_hi(w.x), bf_lo(w.y), bf_hi(w.y)}; b = (f32x4){bf_lo(w.z), bf_hi(w.z), bf_lo(w.w), bf_hi(w.w)};
}

namespace pg8 {
constexpr int BM = 256, BK = 64, HALF = 128, HTB = HALF * BK * 2, STAGE_BYTES = 8 * HTB, NXCD = 8, WGM = 8;
__host__ __device__ __forceinline__ int lds_byte(int r, int c) { const int st = (r >> 4) * 2 + (c >> 5), rr = r & 15, cc = c & 31, ob = rr * 64 + cc * 2; return st * 1024 + (ob ^ (((ob >> 9) & 1) << 5)); }
__host__ __device__ __forceinline__ void stage_rc(int b, int& R, int& C) { const int st = b / 1024, sb = b % 1024, swz = sb ^ (((sb >> 9) & 1) << 5); R = (st >> 1) * 16 + swz / 64; C = (st & 1) * 32 + (swz % 64) / 2; }
__host__ __device__ __forceinline__ int perm32(int rho) { const int n = rho >> 4, i = rho & 15; return 8 * (i >> 2) + 4 * n + (i & 3); }

constexpr int RSTD_OFF = 131072, RSTD_UNITS = 6;
struct Unit { int pm, pn; long aoff, boff; };
struct Gemm { const bf16_t* A; const bf16_t* Bt; int lda, ldb, K; };

struct Sched {
    int nM, nN, nwg, G, c, a_sh, b_sh, mode, i0, i1; long a_pm, a_pn, b_pm, b_pn;
    __device__ __forceinline__ void init(int nM_, int nN_, int G_, int c_, long apm, long apn, int ash, long bpm, int bsh, long bpn) {
        nM = nM_; nN = nN_; nwg = nM * nN; G = G_; c = c_; mode = 0; i0 = 0; i1 = 1 << 20; a_pm = apm; a_pn = apn; a_sh = ash; b_pm = bpm; b_sh = bsh; b_pn = bpn; }
    __device__ __forceinline__ void init_plain(int nM_, int nN_, int G_, int c_, int lda, int ldb) { init(nM_, nN_, G_, c_, (long)BM * lda * 2, 0, 0, 0, 0, (long)BM * ldb * 2); }
    __device__ __forceinline__ bool next(int i, Unit& u) const {
        if (i + i0 >= i1) return false;
        const long L = (long)(i + i0) * G + c; if (L >= nwg) return false;
        int wgid = (int)L; { const int q = nwg / NXCD, r = nwg % NXCD, xcd = wgid % NXCD, off = wgid / NXCD; wgid = (xcd < r ? xcd * (q + 1) : r * (q + 1) + (xcd - r) * q) + off; }
        const int nig = WGM * nN, gid = wgid / nig, fm = gid * WGM, gsz = (nM - fm) < WGM ? (nM - fm) : WGM;
        u.pm = fm + ((wgid % nig) % gsz); u.pn = (wgid % nig) / gsz;
        u.aoff = (long)u.pm * a_pm + (long)(u.pn >> a_sh) * a_pn; u.boff = (long)(u.pm >> b_sh) * b_pm + (long)u.pn * b_pn;
        if (mode == 1) {
            u.aoff = (long)(u.pm >> 2) * (256L * 16384 * 2) + (long)(u.pm & 3) * 1024; u.boff = (long)(u.pm & 3) * 1024 + (long)u.pn * (256L * 2048 * 2); }
        else if (mode == 2) {
            u.aoff = (long)(u.pm & 7) * (256L * 2048 * 2) + (long)u.pn * 1024; u.boff = (long)(u.pm >> 3) * (256L * 16384 * 2) + (long)u.pn * 1024; }
        return true;
    }
};

template <class Epi, bool ALIGN_EPI = true, bool F16 = false>
__device__ __forceinline__ void gemm_phase(LAS unsigned char* lds, const Gemm g, const Sched& S, const Epi& E) {
    int tid = threadIdx.x; asm volatile("" : "+v"(tid));
    const int wid = __builtin_amdgcn_readfirstlane(tid >> 6), lane = tid & 63, wr = wid >> 2, wc = wid & 3, fr = lane & 15, fq = lane >> 4;
    int K = g.K; asm volatile("" : "+s"(K));
    const int nt = K / BK;
    unsigned voffA[2], voffB[2];
#pragma unroll
    for (int i = 0; i < 2; ++i) { int R, C; stage_rc(tid * 16 + i * 8192, R, C); const int Rb = (R & ~31) + perm32(R & 31);
        voffA[i] = (unsigned)(R * g.lda + C) * 2u; voffB[i] = (unsigned)(Rb * g.ldb + C) * 2u; }
    const size_t kstep = (size_t)(BK * 2);
    const size_t hstepA = (size_t)HALF * g.lda * 2, hstepB = (size_t)HALF * g.ldb * 2;
    const unsigned ldsw = (unsigned)wid * 1024u;
    const int aoff = lds_byte(wr * 64 + fr, fq * 8), boff = lds_byte(wc * 32 + fr, fq * 8);
#define PG8_SA(b, h) (((b) * 2 + (h)) * HTB)
#define PG8_SB(b, h) ((4 + (b) * 2 + (h)) * HTB)
#define PG8_STAGE(bufoff, gbase, voff) do { _Pragma("unroll") for (int _i = 0; _i < 2; ++_i) \
        __builtin_amdgcn_global_load_lds((const unsigned*)((const char*)(gbase) + (voff)[_i]), (LAS unsigned*)(lds + (bufoff) + ldsw + _i * 8192), 16, 0, 0); } while (0)
#define PG8_LDA(dst, b, h) do { _Pragma("unroll") for (int m = 0; m < 4; ++m) _Pragma("unroll") for (int k = 0; k < 2; ++k) dst[m][k] = *(const LAS bf16x8*)(lds + PG8_SA(b, h) + aoff + m * 2048 + k * 1024); } while (0)
#define PG8_LDB(dst, b, h) do { _Pragma("unroll") for (int n = 0; n < 2; ++n) _Pragma("unroll") for (int k = 0; k < 2; ++k) dst[n][k] = *(const LAS bf16x8*)(lds + PG8_SB(b, h) + boff + n * 2048 + k * 1024); } while (0)
#define PG8_MMA(ai, bj, At, Bt) do { __builtin_amdgcn_s_setprio(1); _Pragma("unroll") for (int m = 0; m < 4; ++m) _Pragma("unroll") for (int n = 0; n < 2; ++n) _Pragma("unroll") for (int k = 0; k < 2; ++k) \
        acc[ai][bj][m][n] = F16 ? __builtin_amdgcn_mfma_f32_16x16x32_f16(__builtin_bit_cast(f16x8_t, Bt[n][k]), __builtin_bit_cast(f16x8_t, At[m][k]), acc[ai][bj][m][n], 0, 0, 0) \
                                : __builtin_amdgcn_mfma_f32_16x16x32_bf16(Bt[n][k], At[m][k], acc[ai][bj][m][n], 0, 0, 0); __builtin_amdgcn_s_setprio(0); } while (0)
#define PG8_WAIT_V(n) asm volatile("s_waitcnt vmcnt(" #n ")" ::: "memory")
#define PG8_WAIT_L(n) asm volatile("s_waitcnt lgkmcnt(" #n ")" ::: "memory")
#define PG8_BAR __builtin_amdgcn_s_barrier()
#define PG8_SCHED __builtin_amdgcn_sched_barrier(0)
    Unit cur, nxt; int ui = 0;
    if (!S.next(0, cur)) return;
    if constexpr (Epi::USES_RSTD) {
        LAS float* T = (LAS float*)(lds + RSTD_OFF);
#pragma unroll
        for (int k = 0; k < RSTD_UNITS * 256 / 512; ++k) { const int idx = tid + 512 * k; Unit uu;
            if (S.next(idx >> 8, uu)) { const float* sp = E.SS + uu.pm * BM + (idx & 255); float ssum = 0.f;
#pragma unroll
                for (int j = 0; j < 8; ++j) ssum += sp[(size_t)j * MROWS];
                T[idx] = __builtin_amdgcn_rsqf(ssum * (1.0f / DM) + EPS); } }
        asm volatile("s_waitcnt lgkmcnt(0)" ::: "memory"); __builtin_amdgcn_s_barrier(); asm volatile("" ::: "memory");
    }
    f32x4 acc[2][2][4][2];
#pragma unroll
    for (int a = 0; a < 2; ++a)
#pragma unroll
        for (int b = 0; b < 2; ++b)
#pragma unroll
            for (int m = 0; m < 4; ++m)
#pragma unroll
                for (int n = 0; n < 2; ++n) acc[a][b][m][n] = (f32x4){0.f, 0.f, 0.f, 0.f};
    bf16x8 At[4][2], B0[2][2], B1[2][2];
    const char* cA = (const char*)g.A + cur.aoff; const char* cB = (const char*)g.Bt + cur.boff;
    PG8_STAGE(PG8_SB(0, 0), cB, voffB); PG8_STAGE(PG8_SB(0, 1), cB + hstepB, voffB); PG8_STAGE(PG8_SA(0, 0), cA, voffA); PG8_STAGE(PG8_SA(0, 1), cA + hstepA, voffA);
    if (wr == 1) PG8_BAR;
    PG8_WAIT_V(2); PG8_BAR;
    PG8_STAGE(PG8_SB(1, 0), cB + kstep, voffB); PG8_STAGE(PG8_SA(1, 0), cA + kstep, voffA); PG8_STAGE(PG8_SB(1, 1), cB + hstepB + kstep, voffB);
    PG8_WAIT_V(6); PG8_BAR;
    for (;;) {
        const bool has_next = S.next(ui + 1, nxt);
        const char* nA = has_next ? (const char*)g.A + nxt.aoff : cA; const char* nB = has_next ? (const char*)g.Bt + nxt.boff : cB;
        for (int hh = 0; hh < (Epi::HAS_MID ? 2 : 1); ++hh) {
        if constexpr (Epi::HAS_MID) { if (hh == 1) { int le = lane; asm volatile("" : "+v"(le)); E.mid(acc, cur, wr, wc, le & 15, le >> 4); } }
        const int t_lo = Epi::HAS_MID ? hh * (nt >> 1) : 0, t_hi = Epi::HAS_MID ? (hh + 1) * (nt >> 1) : nt;
        for (int t = t_lo; t < t_hi; t += 2) {
            const bool last = (t == nt - 2);
            const char* a1 = cA + (size_t)(t + 1) * kstep;
            const char* a2 = last ? nA : cA + (size_t)(t + 2) * kstep; const char* b2 = last ? nB : cB + (size_t)(t + 2) * kstep;
            const char* a3 = a2 + kstep; const char* b3 = b2 + kstep;
            PG8_LDB(B0, 0, 0); PG8_LDB(B1, 0, 1); PG8_SCHED; PG8_LDA(At, 0, 0); PG8_STAGE(PG8_SA(1, 1), a1 + hstepA, voffA);
            PG8_WAIT_V(8); PG8_WAIT_L(0); PG8_BAR; PG8_MMA(0, 0, At, B0); PG8_MMA(0, 1, At, B1); PG8_BAR; PG8_SCHED;
            PG8_LDA(At, 0, 1); PG8_STAGE(PG8_SB(0, 0), b2, voffB); PG8_STAGE(PG8_SB(0, 1), b2 + hstepB, voffB); PG8_STAGE(PG8_SA(0, 0), a2, voffA);
            PG8_WAIT_V(8); PG8_WAIT_L(0); PG8_BAR; PG8_MMA(1, 0, At, B0); PG8_MMA(1, 1, At, B1); PG8_BAR; PG8_SCHED;
            PG8_LDB(B0, 1, 0); PG8_LDB(B1, 1, 1); PG8_SCHED; PG8_LDA(At, 1, 0); PG8_STAGE(PG8_SA(0, 1), a2 + hstepA, voffA);
            PG8_WAIT_V(8); PG8_WAIT_L(0); PG8_BAR; PG8_MMA(0, 0, At, B0); PG8_MMA(0, 1, At, B1); PG8_BAR; PG8_SCHED;
            PG8_LDA(At, 1, 1); PG8_STAGE(PG8_SB(1, 0), b3, voffB); PG8_STAGE(PG8_SB(1, 1), b3 + hstepB, voffB); PG8_STAGE(PG8_SA(1, 0), a3, voffA);
            PG8_WAIT_V(8); PG8_WAIT_L(0); PG8_BAR; PG8_MMA(1, 0, At, B0); PG8_MMA(1, 1, At, B1); PG8_BAR; PG8_SCHED;
        }
        }
        if constexpr (ALIGN_EPI) { if (wr == 0) PG8_BAR; }
        if constexpr (!Epi::AFTER_DRAIN) { int le = lane; asm volatile("" : "+v"(le));
            E(acc, cur, wr, wc, le & 15, le >> 4, ui, lds); }
        if (!has_next) break;
#pragma unroll
        for (int a = 0; a < 2; ++a)
#pragma unroll
            for (int b = 0; b < 2; ++b)
#pragma unroll
                for (int m = 0; m < 4; ++m)
#pragma unroll
                    for (int n = 0; n < 2; ++n) acc[a][b][m][n] = (f32x4){0.f, 0.f, 0.f, 0.f};
        cur = nxt; cA = nA; cB = nB; ++ui;
        if constexpr (ALIGN_EPI) { if (wr == 1) PG8_BAR; }
    }
    PG8_WAIT_V(0);
    if constexpr (!ALIGN_EPI) { if (wr == 0) PG8_BAR; }
    PG8_BAR;
    if constexpr (Epi::AFTER_DRAIN) { int le = lane; asm volatile("" : "+v"(le)); E.fused(acc, cur, wr, wc, le & 15, le >> 4, lds, wid, le); }
#undef PG8_SA
#undef PG8_SB
#undef PG8_STAGE
#undef PG8_LDA
#undef PG8_LDB
#undef PG8_MMA
#undef PG8_WAIT_V
#undef PG8_WAIT_L
#undef PG8_BAR
#undef PG8_SCHED
}

#define ROWG(base, u, ai, m, wr, ld, esz) ((char*)(base) + (size_t)((u).pm * BM + (ai) * HALF + (wr) * 64 + (m) * 16) * (size_t)(ld) * (esz))
__device__ __forceinline__ void load_rstd(const float* SS, const Unit& u, int wr, int fr, int fq, float (&rs)[2][4]) {
    const unsigned loff = (unsigned)((2 * fq) * MROWS + fr) * 4u;
#pragma unroll
    for (int ai = 0; ai < 2; ++ai)
#pragma unroll
        for (int m = 0; m < 4; ++m) { const char* sb = (const char*)(SS + (u.pm * BM + ai * HALF + wr * 64 + m * 16)); const char* sb2 = sb + (size_t)MROWS * 4;
            float s = *(const float*)(sb + loff) + *(const float*)(sb2 + loff);
            s += __shfl_xor(s, 16); s += __shfl_xor(s, 32);
            rs[ai][m] = __builtin_amdgcn_rsqf(s * (1.0f / DM) + EPS); }
}

__device__ __forceinline__ void read_rstd(LAS unsigned char* lds, int ui, int wr, int fr, float (&rs)[2][4]) {
    const LAS float* T = (const LAS float*)(lds + RSTD_OFF) + ui * 256 + wr * 64 + fr;
#pragma unroll
    for (int ai = 0; ai < 2; ++ai)
#pragma unroll
        for (int m = 0; m < 4; ++m) rs[ai][m] = T[ai * HALF + m * 16];
}
__host__ __device__ __forceinline__ int zperm(int t) { return (t == 16 || t == 17) ? t + 4 : ((t == 20 || t == 21) ? t - 4 : t); }
struct EpiZ {
    static constexpr bool USES_RSTD = true, AFTER_DRAIN = false, HAS_MID = false;
    bf16_t *ZP, *Q, *KK, *V, *OG, *GA, *GB; float* G; const float* SS; const float* LB;
    __device__ __forceinline__ void operator()(const f32x4 (&acc)[2][2][4][2], const Unit& u, int wr, int wc, int fr, int fq, int ui, LAS unsigned char* lds) const {
        const int cl = wc * 32 + 8 * fq; const int pn = zperm(u.pn);
        float rs[2][4]; read_rstd(lds, ui, wr, fr, rs);
        if (pn >= 8 && pn < 12) {
            const int cb = (pn - 8) * 256 + cl;
            const unsigned lo4 = (unsigned)(fr * HDIM + cb) * 4u, lo2 = (unsigned)(fr * HDIM + cb) * 2u;
#pragma unroll
            for (int bj = 0; bj < 2; ++bj) {
                const f32x4 l0 = *(const f32x4*)(LB + cb + bj * HALF), l1 = *(const f32x4*)(LB + cb + bj * HALF + 4);
#pragma unroll
                for (int ai = 0; ai < 2; ++ai)
#pragma unroll
                    for (int m = 0; m < 4; ++m) { const float r = rs[ai][m];
                        f32x4 gg[2], kk[2];
#pragma unroll
                        for (int n = 0; n < 2; ++n) { const f32x4 lb = n ? l1 : l0;
#pragma unroll
                            for (int j = 0; j < 4; ++j) { float z = acc[ai][bj][m][n][j] * r; z = fminf(fmaxf(z, -80.f), 80.f);
                                const float e = ex2(-z * LOG2E), sg = rcpf_(1.0f + e), om = 1.0f - lb[j];
                                gg[n][j] = __builtin_amdgcn_logf(lb[j] + om * sg); kk[n][j] = om * e * sg; } }
                        char* gb = ROWG(G, u, ai, m, wr, HDIM, 4) + bj * HALF * 4; char* kb = ROWG(KK, u, ai, m, wr, HDIM, 2) + bj * HALF * 2;
                        *(f32x4*)(gb + lo4) = gg[0]; *(f32x4*)(gb + lo4 + 16) = gg[1];
                        st_bf16x8((bf16_t*)(kb + lo2), kk[0], kk[1]); } }
        } else {
            bf16_t* dst; int ld, cb, ty;
            if (pn < 4) { dst = ZP; ld = PD; cb = pn * 256; ty = 0; }
            else if (pn < 8) { dst = Q; ld = HDIM; cb = (pn - 4) * 256; ty = 1; }
            else if (pn < 16) { dst = V; ld = HDIM; cb = (pn - 12) * 256; ty = 0; }
            else if (pn < 20) { dst = OG; ld = HDIM; cb = (pn - 16) * 256; ty = 1; }
            else if (pn < 28) { dst = GA; ld = DM; cb = (pn - 20) * 256; ty = 2; }
            else { dst = GB; ld = DM; cb = (pn - 28) * 256; ty = 2; }
            const unsigned loff = (unsigned)(fr * ld + cb + cl) * 2u;
#define EPZ_LOOP(BODY) _Pragma("unroll") for (int ai = 0; ai < 2; ++ai) _Pragma("unroll") for (int m = 0; m < 4; ++m) { const float r = rs[ai][m]; const float rn = -r * LOG2E; (void)rn; char* rb = ROWG(dst, u, ai, m, wr, ld, 2); \
                _Pragma("unroll") for (int bj = 0; bj < 2; ++bj) { f32x4 v[2]; _Pragma("unroll") for (int n = 0; n < 2; ++n) { const f32x4 a = acc[ai][bj][m][n]; BODY } \
                    st_bf16x8((bf16_t*)(rb + loff + bj * HALF * 2), v[0], v[1]); } }
            if (ty == 0) { EPZ_LOOP( v[n] = a * r; ) }
            else if (ty == 1) { EPZ_LOOP( const f32x4 t = a * rn; f32x4 e; e[0] = ex2(t[0]); e[1] = ex2(t[1]); e[2] = ex2(t[2]); e[3] = ex2(t[3]); const f32x4 d = e + 1.0f;
                                          f32x4 sg; sg[0] = rcpf_(d[0]); sg[1] = rcpf_(d[1]); sg[2] = rcpf_(d[2]); sg[3] = rcpf_(d[3]); v[n] = (a * r) * sg; ) }
            else { EPZ_LOOP( const f32x4 t = a * rn; f32x4 e; e[0] = ex2(t[0]); e[1] = ex2(t[1]); e[2] = ex2(t[2]); e[3] = ex2(t[3]); const f32x4 d = e + 1.0f;
                             f32x4 sg; sg[0] = rcpf_(d[0]); sg[1] = rcpf_(d[1]); sg[2] = rcpf_(d[2]); sg[3] = rcpf_(d[3]); v[n] = sg; ) }
#undef EPZ_LOOP
        }
    }
};
struct EpiRowScale {
    static constexpr bool USES_RSTD = false, AFTER_DRAIN = false, HAS_MID = false;
    bf16_t* O; int ldc; const float* SS; const float* RS; float cst;
    __device__ __forceinline__ void operator()(const f32x4 (&acc)[2][2][4][2], const Unit& u, int wr, int wc, int fr, int fq, int ui, LAS unsigned char* lds) const {
        const unsigned loff = (unsigned)(fr * ldc + u.pn * BM + wc * 32 + 8 * fq) * 2u;
        float rs[2][4];
        if (SS) load_rstd(SS, u, wr, fr, fq, rs);
        else {
#pragma unroll
            for (int ai = 0; ai < 2; ++ai)
#pragma unroll
                for (int m = 0; m < 4; ++m) rs[ai][m] = *(const float*)((const char*)(RS + (u.pm * BM + ai * HALF + wr * 64 + m * 16)) + (unsigned)fr * 4u); }
#pragma unroll
        for (int ai = 0; ai < 2; ++ai)
#pragma unroll
            for (int m = 0; m < 4; ++m) { const float r = rs[ai][m] * cst; char* rb = ROWG(O, u, ai, m, wr, ldc, 2);
#pragma unroll
                for (int bj = 0; bj < 2; ++bj) st_bf16x8((bf16_t*)(rb + loff + bj * HALF * 2), acc[ai][bj][m][0] * r, acc[ai][bj][m][1] * r); }
    }
};
struct EpiColScale {
    static constexpr bool USES_RSTD = false, AFTER_DRAIN = false, HAS_MID = false;
    bf16_t* O; int ldc; const float* CS; int f16;
    __device__ __forceinline__ void operator()(const f32x4 (&acc)[2][2][4][2], const Unit& u, int wr, int wc, int fr, int fq, int ui, LAS unsigned char* lds) const {
        const int col0 = u.pn * BM + wc * 32 + 8 * fq; const unsigned loff = (unsigned)(fr * ldc + col0) * 2u;
        f32x4 cs[2][2];
#pragma unroll
        for (int bj = 0; bj < 2; ++bj)
#pragma unroll
            for (int n = 0; n < 2; ++n) cs[bj][n] = CS ? *(const f32x4*)(CS + col0 + bj * HALF + 4 * n) : (f32x4){1.f, 1.f, 1.f, 1.f};
#pragma unroll
        for (int ai = 0; ai < 2; ++ai)
#pragma unroll
            for (int m = 0; m < 4; ++m) { char* rb = ROWG(O, u, ai, m, wr, ldc, 2);
#pragma unroll
                for (int bj = 0; bj < 2; ++bj) { if (f16) st_f16x8((bf16_t*)(rb + loff + bj * HALF * 2), acc[ai][bj][m][0] * cs[bj][0], acc[ai][bj][m][1] * cs[bj][1]);
                                                 else st_bf16x8((bf16_t*)(rb + loff + bj * HALF * 2), acc[ai][bj][m][0] * cs[bj][0], acc[ai][bj][m][1] * cs[bj][1]); } }
    }
};
struct EpiFfn {
    static constexpr bool USES_RSTD = true, AFTER_DRAIN = false, HAS_MID = false;
    bf16_t* ACT; const float* SS;
    __device__ __forceinline__ void operator()(const f32x4 (&acc)[2][2][4][2], const Unit& u, int wr, int wc, int fr, int fq, int ui, LAS unsigned char* lds) const {
        const unsigned loff = (unsigned)(fr * DFF + u.pn * HALF + wc * 32 + 8 * fq) * 2u;
        float rs[2][4]; read_rstd(lds, ui, wr, fr, rs);
#pragma unroll
        for (int ai = 0; ai < 2; ++ai)
#pragma unroll
            for (int m = 0; m < 4; ++m) { const float r = rs[ai][m], rn = -r * LOG2E, rr = r * r; f32x4 v[2]; char* rb = ROWG(ACT, u, ai, m, wr, DFF, 2);
#pragma unroll
                for (int n = 0; n < 2; ++n) { const f32x4 g = acc[ai][0][m][n], up = acc[ai][1][m][n]; const f32x4 t = g * rn;
                    f32x4 e; e[0] = ex2(t[0]); e[1] = ex2(t[1]); e[2] = ex2(t[2]); e[3] = ex2(t[3]); const f32x4 d = e + 1.0f;
                    f32x4 sg; sg[0] = rcpf_(d[0]); sg[1] = rcpf_(d[1]); sg[2] = rcpf_(d[2]); sg[3] = rcpf_(d[3]);
                    v[n] = ((g * up) * rr) * sg; }
                st_bf16x8((bf16_t*)(rb + loff), v[0], v[1]); }
    }
};
struct EpiBranch {
    static constexpr bool USES_RSTD = false, AFTER_DRAIN = false, HAS_MID = true;
    bf16_t* O; const bf16_t* GA; const bf16_t* GB;
    __device__ __forceinline__ void mid(f32x4 (&acc)[2][2][4][2], const Unit& u, int wr, int wc, int fr, int fq) const {
        const unsigned loff = (unsigned)(fr * DM + u.pn * BM + wc * 32 + 8 * fq) * 2u;
#pragma unroll
        for (int ai = 0; ai < 2; ++ai) {
            u32x4 ga[4][2], gb[4][2];
#pragma unroll
            for (int m = 0; m < 4; ++m) { const char* pa = ROWG(GA, u, ai, m, wr, DM, 2); const char* pb = ROWG(GB, u, ai, m, wr, DM, 2);
#pragma unroll
                for (int bj = 0; bj < 2; ++bj) { ga[m][bj] = *(const u32x4*)(pa + loff + bj * HALF * 2); gb[m][bj] = *(const u32x4*)(pb + loff + bj * HALF * 2); } }
#pragma unroll
            for (int m = 0; m < 4; ++m)
#pragma unroll
                for (int bj = 0; bj < 2; ++bj) { const u32x4 a = ga[m][bj], g = gb[m][bj];
                    const f32x4 a0 = {bf_lo(a.x), bf_hi(a.x), bf_lo(a.y), bf_hi(a.y)}, a1 = {bf_lo(a.z), bf_hi(a.z), bf_lo(a.w), bf_hi(a.w)};
                    const f32x4 b0 = {bf_lo(g.x), bf_hi(g.x), bf_lo(g.y), bf_hi(g.y)}, b1 = {bf_lo(g.z), bf_hi(g.z), bf_lo(g.w), bf_hi(g.w)};
#pragma unroll
                    for (int j = 0; j < 4; ++j) { acc[ai][bj][m][0][j] *= a0[j] * rcpf_(b0[j]); acc[ai][bj][m][1][j] *= a1[j] * rcpf_(b1[j]); } }
            asm volatile("" ::: "memory"); }
    }
    __device__ __forceinline__ void operator()(const f32x4 (&acc)[2][2][4][2], const Unit& u, int wr, int wc, int fr, int fq, int ui, LAS unsigned char* lds) const {
        const unsigned loff = (unsigned)(fr * DM + u.pn * BM + wc * 32 + 8 * fq) * 2u;
        u32x4 gb[2][4][2];
#pragma unroll
        for (int ai = 0; ai < 2; ++ai)
#pragma unroll
            for (int m = 0; m < 4; ++m) { const char* pb = ROWG(GB, u, ai, m, wr, DM, 2);
#pragma unroll
                for (int bj = 0; bj < 2; ++bj) gb[ai][m][bj] = *(const u32x4*)(pb + loff + bj * HALF * 2); }
#pragma unroll
        for (int ai = 0; ai < 2; ++ai)
#pragma unroll
            for (int m = 0; m < 4; ++m) { char* ob = ROWG(O, u, ai, m, wr, DM, 2);
#pragma unroll
                for (int bj = 0; bj < 2; ++bj) { const u32x4 g = gb[ai][m][bj];
                    const f32x4 b0 = {bf_lo(g.x), bf_hi(g.x), bf_lo(g.y), bf_hi(g.y)}, b1 = {bf_lo(g.z), bf_hi(g.z), bf_lo(g.w), bf_hi(g.w)};
                    st_bf16x8((bf16_t*)(ob + loff + bj * HALF * 2), acc[ai][bj][m][0] * b0, acc[ai][bj][m][1] * b1); } }
    }
};
struct EpiRes {
    static constexpr bool USES_RSTD = false, AFTER_DRAIN = true, HAS_MID = false;
    bf16_t* HB; float* SS;
    __device__ __forceinline__ void fused(f32x4 (&acc)[2][2][4][2], const Unit& u, int wr, int wc, int fr, int fq, LAS unsigned char* lds, int wid, int lane) const {
        LAS float* P = (LAS float*)lds;
        const unsigned lo2 = (unsigned)(fr * DM + u.pn * BM + wc * 32 + 8 * fq) * 2u;
        u32x4 hv[2][4][2];
#pragma unroll
        for (int ai = 0; ai < 2; ++ai)
#pragma unroll
            for (int m = 0; m < 4; ++m) { const char* hb2 = ROWG(HB, u, ai, m, wr, DM, 2);
#pragma unroll
                for (int bj = 0; bj < 2; ++bj) hv[ai][m][bj] = *(const u32x4*)(hb2 + lo2 + bj * HALF * 2); }
#pragma unroll
        for (int ai = 0; ai < 2; ++ai)
#pragma unroll
            for (int m = 0; m < 4; ++m) { const int rl = ai * HALF + wr * 64 + m * 16 + fr; char* hb2 = ROWG(HB, u, ai, m, wr, DM, 2); float s = 0.f;
#pragma unroll
                for (int bj = 0; bj < 2; ++bj) { const u32x4 w = hv[ai][m][bj];
                    const f32x4 h0 = (f32x4){hf_lo(w.x), hf_hi(w.x), hf_lo(w.y), hf_hi(w.y)} + acc[ai][bj][m][0], h1 = (f32x4){hf_lo(w.z), hf_hi(w.z), hf_lo(w.w), hf_hi(w.w)} + acc[ai][bj][m][1];
                    st_f16x8((bf16_t*)(hb2 + lo2 + bj * HALF * 2), h0, h1);
                    s += (h0[0] * h0[0] + h0[1] * h0[1]) + (h0[2] * h0[2] + h0[3] * h0[3]) + (h1[0] * h1[0] + h1[1] * h1[1]) + (h1[2] * h1[2] + h1[3] * h1[3]); }
                s += __shfl_xor(s, 16); s += __shfl_xor(s, 32);
                if (fq == 0) P[rl * 4 + wc] = s; }
        asm volatile("s_waitcnt lgkmcnt(0)" ::: "memory"); __builtin_amdgcn_s_barrier(); asm volatile("" ::: "memory");
        const int tid = wid * 64 + lane;
        if (tid < 256) { const f32x4 p = *(const LAS f32x4*)(P + tid * 4); SS[(size_t)u.pn * MROWS + u.pm * BM + tid] = (p[0] + p[1]) + (p[2] + p[3]); }
        asm volatile("s_waitcnt lgkmcnt(0)" ::: "memory"); __builtin_amdgcn_s_barrier(); asm volatile("" ::: "memory");
    }
};
struct EpiSoftmax {
    static constexpr bool USES_RSTD = false, AFTER_DRAIN = true, HAS_MID = false;
    bf16_t* P; int ldc; const float* SS; float cst;
    __device__ __forceinline__ void fused(f32x4 (&acc)[2][2][4][2], const Unit& u, int wr, int wc, int fr, int fq, LAS unsigned char* lds, int wid, int lane) const {
        LAS float* X1 = (LAS float*)lds; LAS float* X2 = (LAS float*)(lds + 4096);
        const unsigned loff = (unsigned)(fr * ldc + u.pn * BM + wc * 32 + 8 * fq) * 2u;
        float rs[2][4]; load_rstd(SS, u, wr, fr, fq, rs);
#pragma unroll
        for (int ai = 0; ai < 2; ++ai)
#pragma unroll
            for (int m = 0; m < 4; ++m) { const int rl = ai * HALF + wr * 64 + m * 16 + fr; const float r = rs[ai][m] * cst; float mx = -3.0e38f;
#pragma unroll
                for (int bj = 0; bj < 2; ++bj)
#pragma unroll
                    for (int n = 0; n < 2; ++n)
#pragma unroll
                        for (int j = 0; j < 4; ++j) { const float v = acc[ai][bj][m][n][j] * r; acc[ai][bj][m][n][j] = v; mx = fmaxf(mx, v); }
                mx = fmaxf(mx, __shfl_xor(mx, 16)); mx = fmaxf(mx, __shfl_xor(mx, 32));
                if (fq == 0) X1[rl * 4 + wc] = mx; }
        asm volatile("s_waitcnt lgkmcnt(0)" ::: "memory"); __builtin_amdgcn_s_barrier(); asm volatile("" ::: "memory");
#pragma unroll
        for (int ai = 0; ai < 2; ++ai)
#pragma unroll
            for (int m = 0; m < 4; ++m) { const int rl = ai * HALF + wr * 64 + m * 16 + fr; const f32x4 q = *(const LAS f32x4*)(X1 + rl * 4);
                const float mx = fmaxf(fmaxf(q[0], q[1]), fmaxf(q[2], q[3])) * LOG2E; float s = 0.f;
#pragma unroll
                for (int bj = 0; bj < 2; ++bj)
#pragma unroll
                    for (int n = 0; n < 2; ++n)
#pragma unroll
                        for (int j = 0; j < 4; ++j) { const float e = ex2(acc[ai][bj][m][n][j] * LOG2E - mx); acc[ai][bj][m][n][j] = e; s += e; }
                s += __shfl_xor(s, 16); s += __shfl_xor(s, 32);
                if (fq == 0) X2[rl * 4 + wc] = s; }
        asm volatile("s_waitcnt lgkmcnt(0)" ::: "memory"); __builtin_amdgcn_s_barrier(); asm volatile("" ::: "memory");
#pragma unroll
        for (int ai = 0; ai < 2; ++ai)
#pragma unroll
            for (int m = 0; m < 4; ++m) { const int rl = ai * HALF + wr * 64 + m * 16 + fr; const f32x4 q = *(const LAS f32x4*)(X2 + rl * 4);
                const float inv = 1.0f / ((q[0] + q[1]) + (q[2] + q[3])); char* rb = ROWG(P, u, ai, m, wr, ldc, 2);
#pragma unroll
                for (int bj = 0; bj < 2; ++bj) st_bf16x8((bf16_t*)(rb + loff + bj * HALF * 2), acc[ai][bj][m][0] * inv, acc[ai][bj][m][1] * inv); }
        asm volatile("s_waitcnt lgkmcnt(0)" ::: "memory"); __builtin_amdgcn_s_barrier(); asm volatile("" ::: "memory");
    }
};
}

constexpr size_t MiB = 1u << 20;
constexpr size_t WS_CTL = 0, CTL_ZERO_BYTES = 1 * MiB;
constexpr size_t WS_LB = 1 * MiB;
constexpr size_t WS_RSM = 1 * MiB + 64 * 1024;
constexpr size_t WS_SS = 1 * MiB + 128 * 1024;
constexpr size_t WS_SSQ = 2 * MiB;
constexpr size_t WS_WL = 4 * MiB;
constexpr size_t WL_WIN = 0, WL_WG = 36 * MiB, WL_WBR = 37 * MiB, WL_WMIX = 45 * MiB, WL_WXQ = 53 * MiB, WL_WXO = 61 * MiB, WL_WFI = 69 * MiB, WL_WFO = 113 * MiB, WL_SIZE = 135 * MiB;
constexpr size_t WS_WK = WS_WL + 4 * WL_SIZE;
constexpr size_t WS_WV = WS_WK + 32 * MiB;
constexpr size_t WS_HB = WS_WV + 32 * MiB;
constexpr size_t WS_ZP = WS_HB + 32 * MiB;
constexpr size_t WS_Q = WS_ZP + 16 * MiB;
constexpr size_t WS_KK = WS_Q + 16 * MiB;
constexpr size_t WS_V = WS_KK + 16 * MiB;
constexpr size_t WS_G = WS_V + 16 * MiB;
constexpr size_t WS_OG = WS_G + 32 * MiB;
constexpr size_t WS_GA = WS_OG + 16 * MiB;
constexpr size_t WS_GB = WS_GA + 32 * MiB;
constexpr size_t WS_POOLED = WS_GB + 32 * MiB;
constexpr size_t WS_AB = WS_POOLED + 16 * MiB;
constexpr size_t WS_ORAW = WS_AB + 32 * MiB;
constexpr size_t WS_MERGED = WS_ORAW + 16 * MiB;
constexpr size_t WS_P = WS_MERGED + 32 * MiB;
constexpr size_t WS_ACT = WS_P + 16 * MiB;
constexpr size_t WS_KVB = WS_ACT + 88 * MiB;
constexpr size_t WS_MQ = WS_KVB + 32 * MiB;
constexpr size_t WS_VW = WS_MQ + 64 * MiB;
constexpr size_t WS_MEMB = WS_VW + 64 * MiB;
constexpr size_t WS_HIMG = WS_MEMB + 4 * MiB;
constexpr size_t WS_HVEC = WS_HIMG + 52 * MiB;
constexpr size_t WS_END = WS_HVEC + 2 * MiB;
constexpr int CW_BAR = 4096;

constexpr int RING_BYTES = 131072, LDS_BYTES = 163840, LDSCTL_OFF = LDS_BYTES - 1024, MISC_OFF = LDSCTL_OFF + 320;
constexpr int NWAVES = 8;

#define XB_TMO      128
#define XB_XCNT(j)  (256  + 64 * (j))
#define XB_XSUB(j)  (1280 + 64 * (j))
#define XB_XGEN(j)  (2304 + 64 * (j))
#define XB_TOP      3328
#define XB_TOPGEN   3392
#define XCD_BAR_WORDS 3456
#define XB_SPIN_CAP (1u << 18)
__device__ __forceinline__ unsigned xb_ld(unsigned* p)              { return __hip_atomic_load(p, __ATOMIC_RELAXED, __HIP_MEMORY_SCOPE_AGENT); }
__device__ __forceinline__ unsigned xb_add(unsigned* p, unsigned v) { return __hip_atomic_fetch_add(p, v, __ATOMIC_RELAXED, __HIP_MEMORY_SCOPE_AGENT); }
__device__ __forceinline__ unsigned xb_xcc_id() { return (unsigned)__builtin_amdgcn_s_getreg((3 << 11) | 20) & 0xFu; }
#define XB_SPIN(cond, bar) do { unsigned _sp = 0; while (cond) { __builtin_amdgcn_s_sleep(1); \
    if ((++_sp & 255u) == 0u) { if (xb_ld(&(bar)[XB_TMO])) break; if (_sp > XB_SPIN_CAP) { atomicAdd(&(bar)[XB_TMO], 1u); break; } } } } while (0)
struct XcdBarrier { unsigned* bar; unsigned x; volatile LAS unsigned* st; };
__device__ __forceinline__ XcdBarrier xcd_barrier_post(unsigned* bar, volatile LAS unsigned* st) {
    XcdBarrier b; b.bar = bar; b.x = xb_xcc_id(); b.st = st;
    if (threadIdx.x == 0) (void)xb_add(&bar[XB_XCNT(b.x)], 1u);
    return b;
}
__device__ __forceinline__ void xcd_barrier_complete(unsigned* bar, unsigned x, unsigned& nloc, unsigned& nx) {
    const unsigned G = gridDim.x * gridDim.y * gridDim.z;
    unsigned sum, cnt, mine, sp = 0u;
    for (;;) {
        sum = 0u; cnt = 0u; mine = 0u;
#pragma unroll
        for (unsigned j = 0; j < 16; ++j) { const unsigned c = xb_ld(&bar[XB_XCNT(j)]); sum += c; cnt += (c > 0u) ? 1u : 0u; mine = (j == x) ? c : mine; }
        if (sum == G) break;
        __builtin_amdgcn_s_sleep(1);
        if ((++sp & 255u) == 0u) { if (xb_ld(&bar[XB_TMO])) break; if (sp > XB_SPIN_CAP) { atomicAdd(&bar[XB_TMO], 1u); break; } }
    }
    nloc = mine > 0u ? mine : 1u; nx = cnt > 0u ? cnt : 1u;
}
__device__ __forceinline__ void xcd_barrier(const XcdBarrier& b) {
    asm volatile("s_waitcnt vmcnt(0)" ::: "memory");
    __syncthreads();
    if (threadIdx.x == 0) {
        unsigned* bar = b.bar;
        __builtin_amdgcn_s_waitcnt(0);
        unsigned nloc = b.st[0], nx = b.st[1];
        if (nloc == 0u) { xcd_barrier_complete(bar, b.x, nloc, nx); b.st[0] = nloc; b.st[1] = nx; }
        const unsigned old = xb_add(&bar[XB_XSUB(b.x)], 1u);
        const unsigned gen = old / nloc;
        if (old + 1u == (gen + 1u) * nloc) {
            __builtin_amdgcn_fence(__ATOMIC_RELEASE, "agent");
            asm volatile("s_waitcnt vmcnt(0)" ::: "memory");
            const unsigned og = xb_add(&bar[XB_TOP], 1u);
            const unsigned tg = og / nx;
            if (og + 1u == (tg + 1u) * nx) xb_add(&bar[XB_TOPGEN], 1u);
            else XB_SPIN(xb_ld(&bar[XB_TOPGEN]) == tg, bar);
            __builtin_amdgcn_fence(__ATOMIC_ACQUIRE, "agent");
            xb_add(&bar[XB_XGEN(b.x)], 1u);
            asm volatile("s_waitcnt vmcnt(0)" ::: "memory");
        } else {
            XB_SPIN(xb_ld(&bar[XB_XGEN(b.x)]) == gen, bar);
            __builtin_amdgcn_fence(__ATOMIC_ACQUIRE, "agent");
            asm volatile("s_waitcnt vmcnt(0)" ::: "memory");
        }
    }
    __syncthreads();
}

struct Frame {
    LAS unsigned char* lds;
    int vcu, G;
    const float* const* in; float* out; unsigned char* ws;
};
#define LDS_WAIT() asm volatile("s_waitcnt lgkmcnt(0)" ::: "memory")
__device__ __forceinline__ int opaque_tid() { int t = threadIdx.x; asm volatile("" : "+v"(t)); return t; }
template <class T> __device__ __forceinline__ T* g_(T* p) { return (T*)(GAS T*)p; }
__device__ __forceinline__ size_t oq(size_t c) { asm volatile("" : "+s"(c)); return c; }
#define PHASE_IDS() const int tid = opaque_tid(), lane = tid & 63, wave = __builtin_amdgcn_readfirstlane(tid >> 6); (void)lane; (void)wave
__device__ __forceinline__ float wave_sum(float v) {
#pragma unroll
    for (int o = 1; o < 64; o <<= 1) v += __shfl_xor(v, o);
    return v;
}

constexpr int IT_WIN = 32 * 144, IT_WG = 64, IT_BR = 16 * 32, IT_SQ = 32 * 32, IT_FI = 32 * 176, IT_FO = 88 * 32;
constexpr int IT_LAYER = IT_WIN + IT_WG + 2 * IT_BR + 5 * IT_SQ + IT_FI + IT_FO;
constexpr int CV_N1 = 8096, CV_N3 = 1024, CV_N2 = 8096, CV_SLOT = CV_N1 + CV_N3 + CV_N2;
constexpr int CV_L0_LATE_LO = 2 * IT_SQ + IT_WIN + IT_WG + 2 * IT_BR + IT_SQ, CV_L0_LATE_HI = CV_L0_LATE_LO + IT_FI + IT_FO;
static_assert(CV_SLOT <= IT_LAYER - 2 * IT_SQ, "the K/V weight items (last in a layer) always belong to the prologue");
struct CvtJob { const float* W; const float* gain; bf16_t* WT; int src_ld, dst_ld, k0, n0, dst_col, plain, f16; long dst_row; };
__device__ __forceinline__ void cvt_decode(const float* const* in, unsigned char* ws, int l, int r, CvtJob& j) {
    unsigned char* wl = ws + WS_WL + (size_t)l * WL_SIZE;
    j.gain = nullptr; j.dst_col = 0; j.src_ld = DM; j.dst_ld = DM; j.plain = 0; j.f16 = 0;
    if (r < IT_SQ) { const int kb = r / 32, nb = r % 32; j.W = g_(in[13]) + (size_t)l * DM * DM; j.gain = g_(in[12]) + l * DM; j.WT = (bf16_t*)(wl + WL_WXQ); j.k0 = 64 * kb; j.n0 = 64 * nb; j.dst_row = 0; j.plain = 1; return; } r -= IT_SQ;
    if (r < IT_SQ) { const int kb = r / 32, nb = r % 32; j.W = g_(in[15]) + (size_t)l * DM * DM; j.WT = (bf16_t*)(wl + WL_WXO); j.k0 = 64 * kb; j.n0 = 64 * nb; j.dst_row = 64 * nb; return; } r -= IT_SQ;
    if (r < IT_WIN) { const int kb = r / 144, nb = r % 144; j.W = g_(in[2]) + (size_t)l * DM * INC; j.src_ld = INC; j.gain = g_(in[10]) + l * DM; j.WT = (bf16_t*)(wl + WL_WIN); j.k0 = 64 * kb; j.n0 = 64 * nb; j.dst_row = 256 * pg8::zperm(nb >> 2) + 64 * (nb & 3); j.f16 = 1; return; } r -= IT_WIN;
    if (r < IT_WG) { const int g = r / 16, rr = r % 16, kb = rr / 4, nb = rr % 4; j.W = g_(in[3]) + (size_t)(l * 4 + g) * 256 * 256; j.src_ld = 256; j.WT = (bf16_t*)(wl + WL_WG); j.dst_ld = 256; j.k0 = 64 * kb; j.n0 = 64 * nb; j.dst_row = g * 256 + 64 * nb; return; } r -= IT_WG;
    if (r < IT_BR) { const int kb = r / 32, nb = r % 32; j.W = g_(in[7]) + (size_t)l * PD * DM; j.WT = (bf16_t*)(wl + WL_WBR); j.k0 = 64 * kb; j.n0 = 64 * nb; j.dst_row = 64 * nb; return; } r -= IT_BR;
    if (r < IT_BR) { const int kb = r / 32, nb = r % 32; j.W = g_(in[8]) + (size_t)l * HDIM * DM; j.WT = (bf16_t*)(wl + WL_WBR); j.k0 = 64 * kb; j.n0 = 64 * nb; j.dst_row = 64 * nb; j.dst_col = PD; return; } r -= IT_BR;
    if (r < IT_SQ) { const int kb = r / 32, nb = r % 32; j.W = g_(in[9]) + (size_t)l * DM * DM; j.WT = (bf16_t*)(wl + WL_WMIX); j.k0 = 64 * kb; j.n0 = 64 * nb; j.dst_row = 64 * nb; return; } r -= IT_SQ;
    if (r < IT_FI) { const int kb = r / 176, nb = r % 176, n0 = 64 * nb, s = n0 / DFF, jj = n0 % DFF; j.W = g_(in[17]) + (size_t)l * DM * 2 * DFF; j.src_ld = 2 * DFF; j.gain = g_(in[16]) + l * DM; j.WT = (bf16_t*)(wl + WL_WFI);
        j.k0 = 64 * kb; j.n0 = n0; j.dst_row = 256 * (jj / 128) + 128 * s + (jj % 128); j.f16 = 1; return; } r -= IT_FI;
    if (r < IT_FO) { const int kb = r / 32, nb = r % 32; j.W = g_(in[18]) + (size_t)l * DFF * DM; j.WT = (bf16_t*)(wl + WL_WFO); j.dst_ld = DFF; j.k0 = 64 * kb; j.n0 = 64 * nb; j.dst_row = 64 * nb; return; } r -= IT_FO;
    if (r < IT_SQ) { const int kb = r / 32, nb = r % 32; j.W = g_(in[14]) + (size_t)l * DM * 2 * DM; j.src_ld = 2 * DM; j.gain = g_(in[11]) + l * DM; j.WT = (bf16_t*)(ws + WS_WK); j.k0 = 64 * kb; j.n0 = 64 * nb; j.dst_row = (long)l * DM + 64 * nb; return; } r -= IT_SQ;
    { const int kb = r / 32, nb = r % 32; j.W = g_(in[14]) + (size_t)l * DM * 2 * DM + DM; j.src_ld = 2 * DM; j.gain = g_(in[11]) + l * DM; j.WT = (bf16_t*)(ws + WS_WV); j.k0 = 64 * kb; j.n0 = 64 * nb; j.dst_row = (long)l * DM + 64 * nb; }
}
__device__ __forceinline__ void cvt_load(const CvtJob& j, f32x4 (&v)[16], int lane) {
    const int kr = lane >> 4, n4 = lane & 15;
#pragma unroll
    for (int i = 0; i < 16; ++i) v[i] = __builtin_nontemporal_load((const f32x4*)(j.W + (size_t)(j.k0 + 4 * i + kr) * j.src_ld + j.n0 + 4 * n4));
}
__device__ __forceinline__ void cvt_store(const CvtJob& j, const f32x4 (&v)[16], LAS float* scr, int lane) {
    const int kr = lane >> 4, n4 = lane & 15, c = lane & 3;
    if (j.plain) {
#pragma unroll
        for (int i = 0; i < 16; ++i) { const int k = j.k0 + 4 * i + kr; const float g = j.gain ? j.gain[k] : 1.0f; const f32x4 x = v[i] * g;
            u32x2 w; w.x = cvt_pk_bf16(x[0], x[1]); w.y = cvt_pk_bf16(x[2], x[3]);
            __builtin_nontemporal_store(w, (u32x2*)(j.WT + (size_t)k * j.dst_ld + j.dst_col + j.n0 + 4 * n4)); }
        return;
    }
#pragma unroll
    for (int h = 0; h < 2; ++h) {
#pragma unroll
        for (int i = 0; i < 8; ++i) { LAS float* s = scr + (4 * i + kr) * 65 + 4 * n4; const f32x4 x = v[8 * h + i]; s[0] = x[0]; s[1] = x[1]; s[2] = x[2]; s[3] = x[3]; }
        f32x4 g0 = {1.f, 1.f, 1.f, 1.f}, g1 = g0;
        if (j.gain) { g0 = *(const f32x4*)(j.gain + j.k0 + 32 * h + 8 * c); g1 = *(const f32x4*)(j.gain + j.k0 + 32 * h + 8 * c + 4); }
        LDS_WAIT(); asm volatile("" ::: "memory");
#pragma unroll
        for (int it = 0; it < 4; ++it) { const int n = 16 * it + (lane >> 2); const LAS float* s = scr + (8 * c) * 65 + n;
            const float x0 = s[0 * 65] * g0[0], x1 = s[1 * 65] * g0[1], x2 = s[2 * 65] * g0[2], x3 = s[3 * 65] * g0[3], x4 = s[4 * 65] * g1[0], x5 = s[5 * 65] * g1[1], x6 = s[6 * 65] * g1[2], x7 = s[7 * 65] * g1[3];
            u32x4 o;
            if (j.f16) { o.x = cvt_pk_f16(x0, x1); o.y = cvt_pk_f16(x2, x3); o.z = cvt_pk_f16(x4, x5); o.w = cvt_pk_f16(x6, x7); }
            else { o.x = cvt_pk_bf16(x0, x1); o.y = cvt_pk_bf16(x2, x3); o.z = cvt_pk_bf16(x4, x5); o.w = cvt_pk_bf16(x6, x7); }
            __builtin_nontemporal_store(o, (u32x4*)(j.WT + (size_t)(j.dst_row + n) * j.dst_ld + j.dst_col + j.k0 + 32 * h + 8 * c)); }
        LDS_WAIT(); asm volatile("" ::: "memory");
    }
}
__device__ __forceinline__ void p_cvt_slot(Frame& F, int l, int first, int count, int part, int nparts) {
    PHASE_IDS();
    LAS float* scr = (LAS float*)(F.lds + wave * 16384);
    unsigned char* ws = F.ws;
    const int step = nparts * NWAVES;
    CvtJob ja, jb; f32x4 va[16], vb[16];
    int r = part * NWAVES + wave;
    if (r < count) { cvt_decode(F.in, ws, l, first + r, ja); cvt_load(ja, va, lane); }
    while (r < count) {
        const int r2 = r + step;
        if (r2 < count) { cvt_decode(F.in, ws, l, first + r2, jb); cvt_load(jb, vb, lane); }
        cvt_store(ja, va, scr, lane);
        if (r2 >= count) break;
        const int r3 = r2 + step;
        if (r3 < count) { cvt_decode(F.in, ws, l, first + r3, ja); cvt_load(ja, va, lane); }
        cvt_store(jb, vb, scr, lane);
        r = r3;
    }
}
__device__ __forceinline__ void cvt_one(const float* const* in, unsigned char* ws, int l, int r, LAS float* scr, int lane) {
    CvtJob j; f32x4 v[16]; cvt_decode(in, ws, l, r, j); cvt_load(j, v, lane); cvt_store(j, v, scr, lane);
}
__device__ __forceinline__ void p_prologue(Frame& F) {
    PHASE_IDS();
    LAS float* scr = (LAS float*)(F.lds + wave * 16384);
    const int gw = F.vcu * NWAVES + wave, NGW = F.G * NWAVES;
    unsigned char* ws = g_(F.ws);
    for (int c = blockIdx.x * 512 + tid; c < HDIM; c += F.G * 512) {
        const float* hl = g_(F.in[5]); float v[4], mx = -3.0e38f;
#pragma unroll
        for (int l = 0; l < 4; ++l) { v[l] = hl[l * HDIM + c]; mx = fmaxf(mx, v[l]); }
        float s = 0.f;
#pragma unroll
        for (int l = 0; l < 4; ++l) { v[l] = expf(v[l] - mx); s += v[l]; }
        const float inv = 1.0f / s; float* LB = (float*)(ws + WS_LB); float cs = 0.f;
        LB[c] = 0.f;
#pragma unroll
        for (int l = 1; l < 4; ++l) { cs += v[l] * inv; LB[l * HDIM + c] = cs; }
    }
    {
        const float* x = g_(F.in[0]); bf16_t* HB = (bf16_t*)(ws + WS_HB); float* SS = (float*)(ws + WS_SS);
        for (int m = gw; m < MROWS; m += NGW) {
            const f32x4* xr = (const f32x4*)(x + (size_t)m * DM) + lane; u32x2* br = (u32x2*)(HB + (size_t)m * DM) + lane;
#pragma unroll
            for (int j = 0; j < 8; ++j) { const f32x4 v = xr[64 * j]; u32x2 w; w.x = cvt_pk_f16(v[0], v[1]); w.y = cvt_pk_f16(v[2], v[3]); br[64 * j] = w;
                const float s = wave_sum((v[0] * v[0] + v[1] * v[1]) + (v[2] * v[2] + v[3] * v[3])); if (lane == 0) SS[(size_t)j * MROWS + m] = s; }
        }
        const float* mem = g_(F.in[1]); bf16_t* MB = (bf16_t*)(ws + WS_MEMB); float* RSM = (float*)(ws + WS_RSM);
        for (int m = gw; m < MEMROWS; m += NGW) {
            const f32x4* xr = (const f32x4*)(mem + (size_t)m * DM) + lane; u32x2* br = (u32x2*)(MB + (size_t)m * DM) + lane; float s = 0.f;
#pragma unroll
            for (int j = 0; j < 8; ++j) { const f32x4 v = xr[64 * j]; u32x2 w; w.x = cvt_pk_bf16(v[0], v[1]); w.y = cvt_pk_bf16(v[2], v[3]); br[64 * j] = w; s += (v[0] * v[0] + v[1] * v[1]) + (v[2] * v[2] + v[3] * v[3]); }
            s = wave_sum(s); if (lane == 0) RSM[m] = __builtin_amdgcn_rsqf(s * (1.0f / DM) + EPS);
        }
    }
    {
        constexpr int REST = IT_LAYER - CV_SLOT, NIT = IT_LAYER + (DEPTH - 1) * REST;
        for (int it = gw; it < NIT; it += NGW) {
            int l = 0, r = it;
            if (it >= IT_LAYER) { const int j = it - IT_LAYER; l = 1 + j / REST; r = CV_SLOT + j % REST; }
            if (l == 0 && r >= CV_L0_LATE_LO && r < CV_L0_LATE_HI) continue;
            cvt_one(F.in, ws, l, r, scr, lane);
        }
    }
}

__device__ __forceinline__ void p_pool(Frame& F) {
    PHASE_IDS();
    const bf16_t* ZP = (const bf16_t*)(F.ws + oq(WS_ZP)); bf16_t* PO = (bf16_t*)(F.ws + oq(WS_POOLED));
    for (int id = F.vcu * 512 + tid; id < (MROWS / 8) * 128; id += F.G * 512) {
        const int cg = id & 127, run = id >> 7, r0 = run * 8, t0 = r0 & (SEQ - 1), w = 2 << (cg >> 5);
        f32x4 s0 = {0.f, 0.f, 0.f, 0.f}, s1 = {0.f, 0.f, 0.f, 0.f};
        for (int j = 1; j < w; ++j) if (t0 - j >= 0) { f32x4 a, b; ld_bf16x8(ZP + (size_t)(r0 - j) * PD + 8 * cg, a, b); s0 += a; s1 += b; }
#pragma unroll
        for (int i = 0; i < 8; ++i) { const int t = t0 + i; f32x4 a, b; ld_bf16x8(ZP + (size_t)(r0 + i) * PD + 8 * cg, a, b); s0 += a; s1 += b;
            const float inv = 1.0f / (float)((t + 1) < w ? (t + 1) : w);
            st_bf16x8(PO + (size_t)(r0 + i) * PD + 8 * cg, s0 * inv - a, s1 * inv - b);
            if (t - w + 1 >= 0) { f32x4 c, d; ld_bf16x8(ZP + (size_t)(r0 + i - w + 1) * PD + 8 * cg, c, d); s0 -= c; s1 -= d; } }
    }
}

typedef float hg_f32x2 __attribute__((ext_vector_type(2)));
template <int CTRL> __device__ __forceinline__ float dpp_t(float v) { return __builtin_bit_cast(float, __builtin_amdgcn_mov_dpp(__builtin_bit_cast(int, v), CTRL, 0xf, 0xf, true)); }
#define dpp_f(v, ctrl) dpp_t<ctrl>(v)
constexpr int HG_IMG_BYTES = 34816, HG_IQP = 0, HG_IKP = 17408, HG_IMG_LDS = 36864;
constexpr int HG_VEC = 384;
constexpr int HG_TOT = 0;
constexpr int HS_IMG = 0, HS_VT = 3 * HG_IMG_LDS, HS_PS = HS_VT + 3 * 2304, HS_ST = HS_PS + 2 * 9216, HS_OI = HS_ST + 3 * 4352, HS_END = HS_OI + 2 * 4096;
static_assert(HS_END <= LDSCTL_OFF, "hgrn scan LDS map");
#define HG_BAR() do { asm volatile("s_waitcnt lgkmcnt(0)" ::: "memory"); __builtin_amdgcn_s_barrier(); asm volatile("" ::: "memory"); } while (0)
__device__ __forceinline__ void hgp_load(const float* G, const bf16_t* Q, const bf16_t* KK, int unit, int wave, int lane, hg_f32x2 (&g)[8], unsigned (&q2)[8], unsigned (&k2)[8]) {
    const int b = unit >> 8, h = (unit >> 5) & 7, c = unit & 31;
    const size_t rb = (size_t)b * SEQ + (size_t)c * 64, colb = (size_t)h * 128 + 2 * lane;
#pragma unroll
    for (int i = 0; i < 8; ++i) { const size_t o = (rb + 8 * wave + i) * HDIM + colb; g[i] = *(const hg_f32x2*)(G + o); q2[i] = *(const unsigned*)(Q + o); k2[i] = *(const unsigned*)(KK + o); }
}
__device__ __forceinline__ void hgp_unit(unsigned char* IMG, float* VEC, LAS unsigned char* L, int unit, int par, int wave, int lane, const hg_f32x2 (&g)[8], const unsigned (&q2)[8], const unsigned (&k2)[8]) {
    hg_f32x2 p[8]; p[0] = g[0];
#pragma unroll
    for (int i = 1; i < 8; ++i) p[i] = p[i - 1] + g[i];
    LAS unsigned char* T = L + HG_TOT + par * 4096;
    *(LAS hg_f32x2*)(T + (wave * 128 + 2 * lane) * 4) = p[7];
    HG_BAR();
    hg_f32x2 offs = {0.f, 0.f}, bmid = {0.f, 0.f}, bl = {0.f, 0.f};
#pragma unroll
    for (int s = 0; s < 8; ++s) { const hg_f32x2 ts = *(const LAS hg_f32x2*)(T + (s * 128 + 2 * lane) * 4); if (s < wave) offs += ts; if (s < 4) bmid += ts; bl += ts; }
    unsigned char* img = IMG + (size_t)unit * HG_IMG_BYTES;
#pragma unroll
    for (int i = 0; i < 8; ++i) { const int t = 8 * wave + i; const hg_f32x2 x = offs + p[i] - bmid;
        const float qa = bf_lo(q2[i]), qb = bf_hi(q2[i]), ka = bf_lo(k2[i]), kb = bf_hi(k2[i]);
        const float ep0 = ex2(fminf(x.x, 126.f)), ep1 = ex2(fminf(x.y, 126.f)), ek0 = ex2(fminf(-x.x, 126.f)), ek1 = ex2(fminf(-x.y, 126.f));
        *(unsigned*)(img + HG_IQP + t * 272 + lane * 4) = cvt_pk_bf16(qa * ep0, qb * ep1);
        *(unsigned*)(img + HG_IKP + t * 272 + lane * 4) = cvt_pk_bf16(ka * ek0, kb * ek1); }
    if (wave == 0) { float* v = VEC + (size_t)unit * HG_VEC + 2 * lane;
        hg_f32x2 d; d.x = ex2(bl.x); d.y = ex2(bl.y); *(hg_f32x2*)v = d;
        hg_f32x2 ci; ci.x = ex2(bmid.x); ci.y = ex2(bmid.y); *(hg_f32x2*)(v + 128) = ci;
        hg_f32x2 cd; cd.x = ex2(bl.x - bmid.x); cd.y = ex2(bl.y - bmid.y); *(hg_f32x2*)(v + 256) = cd; }
}
__device__ __forceinline__ void p_hgrn_pre(Frame& F) {
    PHASE_IDS();
    const bf16_t* Q = (const bf16_t*)(F.ws + oq(WS_Q)); const bf16_t* KK = (const bf16_t*)(F.ws + oq(WS_KK)); const float* G = (const float*)(F.ws + oq(WS_G));
    unsigned char* IMG = F.ws + oq(WS_HIMG); float* VEC = (float*)(F.ws + oq(WS_HVEC));
    hg_f32x2 ga[8], gb[8]; unsigned qa[8], qb[8], ka[8], kb[8];
    int u = blockIdx.x;
    if (u < 1024) hgp_load(G, Q, KK, u, wave, lane, ga, qa, ka);
    while (u < 1024) {
        const int u2 = u + F.G;
        if (u2 < 1024) hgp_load(G, Q, KK, u2, wave, lane, gb, qb, kb);
        hgp_unit(IMG, VEC, F.lds, u, 0, wave, lane, ga, qa, ka);
        if (u2 >= 1024) break;
        const int u3 = u2 + F.G;
        if (u3 < 1024) hgp_load(G, Q, KK, u3, wave, lane, ga, qa, ka);
        hgp_unit(IMG, VEC, F.lds, u2, 1, wave, lane, gb, qb, kb);
        u = u3;
    }
    HG_BAR();
}
struct HgCtx { const bf16_t* V; const unsigned char* IMG; const float* VEC; bf16_t* ORAW; float* SSQ; LAS unsigned char* L; int tid, lane, wave, lr, lq, b, h, vs, ubase; unsigned voff; };
__device__ __forceinline__ void hgs_dma(const HgCtx& X, int c, int buf) {
    const char* src = (const char*)X.IMG + (size_t)(X.ubase + c) * HG_IMG_BYTES + (size_t)X.wave * 1024 + X.voff;
    const unsigned dst = (unsigned)__builtin_amdgcn_readfirstlane((int)(unsigned)(size_t)(X.L + HS_IMG + buf * HG_IMG_LDS + X.wave * 1024));
#pragma unroll
    for (int i = 0; i < 9; ++i) { unsigned keep; const char* g = src + i * 4096; const unsigned d = dst + (unsigned)i * 4096u;
        asm volatile("s_mov_b32 %0, m0\n\ts_mov_b32 m0, %2\n\ts_nop 0\n\tglobal_load_lds_dwordx4 %1, off\n\ts_mov_b32 m0, %0" : "=&s"(keep) : "v"(g), "s"(d) : "memory"); }
}
__device__ __forceinline__ unsigned hgs_vload(const HgCtx& X, int c, int k) {
    const int cc = c < SEQ / 64 ? c : SEQ / 64 - 1, idx = (X.tid & 255) + 256 * k;
    return *(const unsigned*)(X.V + ((size_t)X.b * SEQ + (size_t)cc * 64 + (idx >> 3)) * HDIM + X.h * 128 + X.vs * 16 + 2 * (idx & 7));
}
__device__ __forceinline__ f32x4 hgs_vec(const HgCtx& X, int c, int tile, int which) {
    const int cc = c < SEQ / 64 ? c : SEQ / 64 - 1;
    return *(const f32x4*)(X.VEC + (size_t)(X.ubase + cc) * HG_VEC + which * 128 + 16 * tile + 4 * X.lq);
}
typedef short hg_s16x4 __attribute__((ext_vector_type(4)));
__device__ __forceinline__ bf16x8 hgs_kpt(LAS unsigned char* KP, int j, int ks, int lane) {
    const int g = lane >> 4, q = (lane & 15) >> 2, p = lane & 3;
    LAS unsigned char* a0 = KP + (32 * ks + 8 * g + q) * 272 + (16 * j + 4 * p) * 2;
    const hg_s16x4 lo = __builtin_amdgcn_ds_read_tr16_b64_v4i16((LAS hg_s16x4*)a0), hi = __builtin_amdgcn_ds_read_tr16_b64_v4i16((LAS hg_s16x4*)(a0 + 4 * 272));
    bf16x8 r; r[0] = lo[0]; r[1] = lo[1]; r[2] = lo[2]; r[3] = lo[3]; r[4] = hi[0]; r[5] = hi[1]; r[6] = hi[2]; r[7] = hi[3]; return r;
}
struct HgSet { unsigned v2a, v2b; f32x4 dd0, dd1, ci0, ci1, cd0, cd1; };
template <int K3>
__device__ __forceinline__ void hgs_step(const HgCtx& X, int c, HgSet& R, f32x4& st0, f32x4& st1) {
    LAS unsigned char* L = X.L; const int wave = X.wave, lr = X.lr, lq = X.lq, tid = X.tid, lane = X.lane;
    const int par = c & 1; const bool main_on = c < SEQ / 64;
    LAS unsigned char* IM = L + HS_IMG + K3 * HG_IMG_LDS; LAS unsigned char* VT = L + HS_VT + K3 * 2304;
    if (wave < 4) {
        if (c + 1 < SEQ / 64) asm volatile("s_waitcnt vmcnt(9)" ::: "memory"); else asm volatile("s_waitcnt vmcnt(0)" ::: "memory");
    } else if (main_on) {
#pragma unroll
        for (int k = 0; k < 2; ++k) { const unsigned v2 = k ? R.v2b : R.v2a; const int idx = (tid & 255) + 256 * k, s = idx >> 3, vp = idx & 7;
            *(LAS bf16_t*)(VT + (2 * vp) * 144 + s * 2) = (bf16_t)(v2 & 0xffffu); *(LAS bf16_t*)(VT + (2 * vp + 1) * 144 + s * 2) = (bf16_t)(v2 >> 16); } }
    HG_BAR();
    if (wave < 4) {
        if (c + 2 < SEQ / 64) hgs_dma(X, c + 2, (K3 + 2) % 3);
        if (main_on) {
            LAS unsigned char* PS = L + HS_PS + par * 9216;
#pragma unroll
            for (int k = 0; k < 3; ++k) {
                int tt, sx; bool on = true;
                if (wave == 0) { tt = k < 2 ? 3 : 0; sx = k < 2 ? k : 0; }
                else if (wave == 1) { tt = k < 2 ? 3 : 1; sx = k < 2 ? 2 + k : 0; }
                else if (wave == 2) { tt = k < 2 ? 2 : 1; sx = k < 2 ? k : 1; }
                else { tt = 2; sx = 2; on = (k == 0); }
                if (on) { f32x4 a = {0.f, 0.f, 0.f, 0.f};
#pragma unroll
                    for (int ks = 0; ks < 4; ++ks) { const bf16x8 A = *(const LAS bf16x8*)(IM + HG_IKP + (16 * sx + lr) * 272 + (32 * ks + 8 * lq) * 2), B = *(const LAS bf16x8*)(IM + HG_IQP + (16 * tt + lr) * 272 + (32 * ks + 8 * lq) * 2);
                        a = __builtin_amdgcn_mfma_f32_16x16x32_bf16(A, B, a, 0, 0, 0); }
                    if (sx == tt) {
#pragma unroll
                        for (int r = 0; r < 4; ++r) if (4 * lq + r > lr) a[r] = 0.f; }
                    u32x2 w; w.x = cvt_pk_bf16(a[0], a[1]); w.y = cvt_pk_bf16(a[2], a[3]);
                    *(LAS u32x2*)(PS + (16 * tt + lr) * 144 + (16 * sx + 4 * lq) * 2) = w; } }
        }
    } else {
        const int wq = wave - 4;
        HgSet N = R; N.v2a = hgs_vload(X, c + 3, 0); N.v2b = hgs_vload(X, c + 3, 1);
        if (main_on) {
            { f32x4 a2 = {0.f, 0.f, 0.f, 0.f}; LAS unsigned char* ST = L + HS_ST + K3 * 4352;
#pragma unroll
              for (int ks = 0; ks < 4; ++ks) { const bf16x8 A = *(const LAS bf16x8*)(IM + HG_IQP + (16 * wq + lr) * 272 + (32 * ks + 8 * lq) * 2), B = *(const LAS bf16x8*)(ST + lr * 272 + (32 * ks + 8 * lq) * 2);
                  a2 = __builtin_amdgcn_mfma_f32_16x16x32_bf16(A, B, a2, 0, 0, 0); }
              LAS float* OI = (LAS float*)(L + HS_OI + par * 4096);
#pragma unroll
              for (int r = 0; r < 4; ++r) OI[(16 * wq + 4 * lq + r) * 16 + lr] = a2[r]; }
            { LAS unsigned char* STn = L + HS_ST + ((K3 + 1) % 3) * 4352; f32x4 t0 = {0.f, 0.f, 0.f, 0.f}, t1 = t0;
#pragma unroll
              for (int ks = 0; ks < 2; ++ks) { const bf16x8 B = *(const LAS bf16x8*)(VT + lr * 144 + (32 * ks + 8 * lq) * 2);
                  const bf16x8 A0 = hgs_kpt(IM + HG_IKP, wq, ks, lane), A1 = hgs_kpt(IM + HG_IKP, wq + 4, ks, lane);
                  t0 = __builtin_amdgcn_mfma_f32_16x16x32_bf16(A0, B, t0, 0, 0, 0); t1 = __builtin_amdgcn_mfma_f32_16x16x32_bf16(A1, B, t1, 0, 0, 0); }
              st0 = st0 * R.dd0 + t0 * R.cd0; st1 = st1 * R.dd1 + t1 * R.cd1;
              const f32x4 s0 = st0 * R.ci0, s1 = st1 * R.ci1;
              u32x2 w; w.x = cvt_pk_bf16(s0[0], s0[1]); w.y = cvt_pk_bf16(s0[2], s0[3]); *(LAS u32x2*)(STn + lr * 272 + (16 * wq + 4 * lq) * 2) = w;
              w.x = cvt_pk_bf16(s1[0], s1[1]); w.y = cvt_pk_bf16(s1[2], s1[3]); *(LAS u32x2*)(STn + lr * 272 + (16 * (wq + 4) + 4 * lq) * 2) = w; }
            N.dd0 = hgs_vec(X, c + 3, wq, 0); N.dd1 = hgs_vec(X, c + 3, wq + 4, 0); N.ci0 = hgs_vec(X, c + 4, wq, 1); N.ci1 = hgs_vec(X, c + 4, wq + 4, 1);
            N.cd0 = hgs_vec(X, c + 3, wq, 2); N.cd1 = hgs_vec(X, c + 3, wq + 4, 2);
        }
        if (c >= 1) {
            LAS unsigned char* PSp = L + HS_PS + (par ^ 1) * 9216; LAS unsigned char* VTp = L + HS_VT + ((K3 + 2) % 3) * 2304; const LAS float* OIp = (const LAS float*)(L + HS_OI + (par ^ 1) * 4096);
            f32x4 a1 = {0.f, 0.f, 0.f, 0.f};
#pragma unroll
            for (int ks = 0; ks < 2; ++ks) { const bf16x8 A = *(const LAS bf16x8*)(PSp + (16 * wq + lr) * 144 + (32 * ks + 8 * lq) * 2), B = *(const LAS bf16x8*)(VTp + lr * 144 + (32 * ks + 8 * lq) * 2);
                a1 = __builtin_amdgcn_mfma_f32_16x16x32_bf16(A, B, a1, 0, 0, 0); }
            const size_t rowb = (size_t)X.b * SEQ + (size_t)(c - 1) * 64;
#pragma unroll
            for (int r = 0; r < 4; ++r) { const size_t row = rowb + 16 * wq + 4 * lq + r; const float o = a1[r] + OIp[(16 * wq + 4 * lq + r) * 16 + lr];
                X.ORAW[row * HDIM + X.h * 128 + X.vs * 16 + lr] = f2bf(o); float ss = o * o;
                ss += dpp_f(ss, 0xB1); ss += dpp_f(ss, 0x4E); ss += dpp_f(ss, 0x141); ss += dpp_f(ss, 0x140);
                if (lr == 0) X.SSQ[row * 64 + X.h * 8 + X.vs] = ss; }
        }
        R = N;
    }
}
__device__ __forceinline__ void hgs_set(const HgCtx& X, int c, int wq, HgSet& R) {
    R.dd0 = hgs_vec(X, c, wq, 0); R.dd1 = hgs_vec(X, c, wq + 4, 0); R.ci0 = hgs_vec(X, c + 1, wq, 1); R.ci1 = hgs_vec(X, c + 1, wq + 4, 1); R.cd0 = hgs_vec(X, c, wq, 2); R.cd1 = hgs_vec(X, c, wq + 4, 2);
}
__device__ __forceinline__ void p_hgrn_scan(Frame& F) {
    PHASE_IDS();
    HgCtx X; X.V = (const bf16_t*)(F.ws + oq(WS_V)); X.IMG = F.ws + oq(WS_HIMG); X.VEC = (const float*)(F.ws + oq(WS_HVEC));
    X.ORAW = (bf16_t*)(F.ws + oq(WS_ORAW)); X.SSQ = (float*)(F.ws + oq(WS_SSQ)); X.L = F.lds; X.tid = tid; X.lane = lane; X.wave = wave; X.lr = lane & 15; X.lq = lane >> 4; X.voff = (unsigned)lane * 16u;
    for (int unit = F.vcu; unit < 256; unit += F.G) {
        X.vs = unit & 7; X.h = (unit >> 3) & 7; X.b = unit >> 6; X.ubase = (X.b * 8 + X.h) * 32;
        for (int i = tid; i < 4352 / 4; i += 512) ((LAS unsigned*)(X.L + HS_ST))[i] = 0u;
        for (int i = tid; i < 2 * 9216 / 4; i += 512) ((LAS unsigned*)(X.L + HS_PS))[i] = 0u;
        f32x4 st0 = {0.f, 0.f, 0.f, 0.f}, st1 = st0;
        const int wq = wave & 3;
        HgSet Ra, Rb, Rc;
        if (wave < 4) { hgs_dma(X, 0, 0); hgs_dma(X, 1, 1); }
        else { Ra.v2a = hgs_vload(X, 0, 0); Ra.v2b = hgs_vload(X, 0, 1); Rb.v2a = hgs_vload(X, 1, 0); Rb.v2b = hgs_vload(X, 1, 1); Rc.v2a = hgs_vload(X, 2, 0); Rc.v2b = hgs_vload(X, 2, 1);
               hgs_set(X, 0, wq, Ra); hgs_set(X, 1, wq, Rb); hgs_set(X, 2, wq, Rc); }
        for (int c = 0; c < SEQ / 64 + 1; c += 3) {
            hgs_step<0>(X, c, Ra, st0, st1);
            hgs_step<1>(X, c + 1, Rb, st0, st1);
            hgs_step<2>(X, c + 2, Rc, st0, st1);
        }
        HG_BAR();
    }
}
#undef HG_BAR
__device__ __forceinline__ void p_hgrn_norm(Frame& F, int layer, int part, int nparts) {
    PHASE_IDS();
    const bf16_t* ORAW = (const bf16_t*)(F.ws + oq(WS_ORAW)); const bf16_t* OG = (const bf16_t*)(F.ws + oq(WS_OG)); const float* SSQ = (const float*)(F.ws + oq(WS_SSQ));
    const float* gain = g_(F.in[6]) + layer * HDIM; bf16_t* AB = (bf16_t*)(F.ws + oq(WS_AB));
    const int cg = tid & 127, h = cg >> 4;
    const f32x4 n0 = *(const f32x4*)(gain + 8 * cg), n1 = *(const f32x4*)(gain + 8 * cg + 4);
    for (int row0 = part * 4 + (tid >> 7); row0 < MROWS; row0 += nparts * 16) {
        f32x4 q0[4], q1[4]; u32x4 ow[4], gw[4];
#pragma unroll
        for (int u = 0; u < 4; ++u) { const int row = row0 + u * nparts * 4; if (row < MROWS) { const float* sq = SSQ + (size_t)row * 64 + h * 8;
            q0[u] = *(const f32x4*)sq; q1[u] = *(const f32x4*)(sq + 4); ow[u] = *(const u32x4*)(ORAW + (size_t)row * HDIM + 8 * cg); gw[u] = *(const u32x4*)(OG + (size_t)row * HDIM + 8 * cg); } }
#pragma unroll
        for (int u = 0; u < 4; ++u) { const int row = row0 + u * nparts * 4; if (row < MROWS) {
            const float ss = ((q0[u][0] + q0[u][1]) + (q0[u][2] + q0[u][3])) + ((q1[u][0] + q1[u][1]) + (q1[u][2] + q1[u][3]));
            const float rstd = __builtin_amdgcn_rsqf(ss * (1.0f / 128.0f) + EPS);
            const f32x4 o0 = {bf_lo(ow[u].x), bf_hi(ow[u].x), bf_lo(ow[u].y), bf_hi(ow[u].y)}, o1 = {bf_lo(ow[u].z), bf_hi(ow[u].z), bf_lo(ow[u].w), bf_hi(ow[u].w)};
            const f32x4 g0 = {bf_lo(gw[u].x), bf_hi(gw[u].x), bf_lo(gw[u].y), bf_hi(gw[u].y)}, g1 = {bf_lo(gw[u].z), bf_hi(gw[u].z), bf_lo(gw[u].w), bf_hi(gw[u].w)};
            st_bf16x8(AB + (size_t)row * DM + PD + 8 * cg, o0 * rstd * n0 * g0, o1 * rstd * n1 * g1); } }
    }
}
__device__ __forceinline__ void p_final(Frame& F) {
    PHASE_IDS();
    const bf16_t* HB = (const bf16_t*)(F.ws + oq(WS_HB)); const float* SS = (const float*)(F.ws + oq(WS_SS)); const float* nf = g_(F.in[19]);
    const int gw = F.vcu * NWAVES + wave, NGW = F.G * NWAVES;
    for (int m = gw; m < MROWS; m += NGW) {
        float s = 0.f;
#pragma unroll
        for (int j = 0; j < 8; ++j) s += SS[(size_t)j * MROWS + m];
        const float rstd = __builtin_amdgcn_rsqf(s * (1.0f / DM) + EPS);
        const u32x4* hr = (const u32x4*)(HB + (size_t)m * DM) + lane; f32x4* orow = (f32x4*)(g_(F.out) + (size_t)m * DM) + 2 * lane; const f32x4* g4 = (const f32x4*)nf + 2 * lane;
#pragma unroll
        for (int j = 0; j < 4; ++j) { const u32x4 w = hr[64 * j];
            orow[128 * j] = (f32x4){hf_lo(w.x), hf_hi(w.x), hf_lo(w.y), hf_hi(w.y)} * rstd * g4[128 * j];
            orow[128 * j + 1] = (f32x4){hf_lo(w.z), hf_hi(w.z), hf_lo(w.w), hf_hi(w.w)} * rstd * g4[128 * j + 1]; }
    }
}

constexpr int PH_PRO = 0, PH_KV = 1, PH_MQ = 2, PH_L0 = 3, PH_PER_LAYER = 10, PH_FINAL = PH_L0 + DEPTH * PH_PER_LAYER, N_PHASES = PH_FINAL + 1;
struct Args { const float* in[20]; float* out; unsigned char* ws; int lo, hi; };
__global__ void __launch_bounds__(NWAVES * 64, 2) mk_fwd(Args args) {
    extern __shared__ __attribute__((aligned(16))) unsigned char lds_raw[];
    Frame F;
    F.lds = (LAS unsigned char*)lds_raw;
    F.G = gridDim.x; { const int bx = blockIdx.x; F.vcu = (F.G % 8 == 0) ? (bx % 8) * (F.G / 8) + bx / 8 : bx; }
    F.in = args.in; F.out = args.out; F.ws = args.ws;
    unsigned char* ws = g_(args.ws);
    for (int u = threadIdx.x; u < (LDS_BYTES - LDSCTL_OFF) / 4; u += NWAVES * 64) ((LAS unsigned*)(F.lds + LDSCTL_OFF))[u] = 0u;
    __syncthreads();
    const int lo = args.lo, hi = args.hi;
    unsigned* barw = (unsigned*)(ws + WS_CTL) + CW_BAR;
    XcdBarrier bar; bar.bar = barw; bar.x = 0; bar.st = (volatile LAS unsigned*)(F.lds + MISC_OFF) + 8;
    if (hi - lo > 1) bar = xcd_barrier_post(barw, (volatile LAS unsigned*)(F.lds + MISC_OFF) + 8);
#ifndef PHMASK
#define PHMASK 0xFFFFF
#endif
#define EN(j) (((PHMASK) >> (j)) & 1)
#define IN(k) (lo <= (k) && (k) < hi)
#define SEAM(k) do { if (IN(k) && IN((k) + 1)) xcd_barrier(bar); } while (0)
    const int G = F.G, c0 = (int)blockIdx.x;
    LAS unsigned char* ring = F.lds;

    if (EN(0) && IN(PH_PRO)) { p_prologue(F); } SEAM(PH_PRO);

    if (EN(1) && IN(PH_KV)) {
        pg8::Gemm g{(const bf16_t*)(ws + WS_MEMB), (const bf16_t*)(ws + WS_WK), DM, DM, DM}; pg8::Sched S; S.init_plain(MEMROWS / 256, 2 * DEPTH * DM / 256, G, c0, DM, DM);
        pg8::EpiRowScale E{(bf16_t*)(ws + WS_KVB), 2 * DEPTH * DM, nullptr, (const float*)(ws + WS_RSM), 1.0f};
        pg8::gemm_phase<pg8::EpiRowScale>(ring, g, S, E);
    } SEAM(PH_KV);

#define FOLD_MQ(ll, cc, GG) do { unsigned char* w_ = ws + oq(0); pg8::Gemm g{(const bf16_t*)(w_ + WS_KVB) + (size_t)(ll) * DM, (const bf16_t*)(w_ + WS_WL + (size_t)(ll) * WL_SIZE + WL_WXQ), 2 * DEPTH * DM, DM, XHD}; \
        pg8::Sched S; S.init(NB * XH, DM / 256, (GG), (cc), 0, 0, 0, 0, 0, 0); S.mode = 1; \
        pg8::EpiColScale E{(bf16_t*)(w_ + WS_MQ) + (size_t)(ll) * NB * XH * MEML * DM, DM, nullptr, 1}; pg8::gemm_phase<pg8::EpiColScale>(ring, g, S, E); } while (0)
#define FOLD_VW(ll, cc, GG) do { unsigned char* w_ = ws + oq(0); pg8::Gemm g{(const bf16_t*)(w_ + WS_WL + (size_t)(ll) * WL_SIZE + WL_WXO), (const bf16_t*)(w_ + WS_KVB) + (size_t)DEPTH * DM + (size_t)(ll) * DM, DM, 2 * DEPTH * DM, XHD}; \
        pg8::Sched S; S.init(NB * DM / 256, XH, (GG), (cc), 0, 0, 0, 0, 0, 0); S.mode = 2; \
        pg8::EpiColScale E{(bf16_t*)(w_ + WS_VW) + (size_t)(ll) * NB * DM * XH * MEML, XH * MEML, nullptr, 0}; pg8::gemm_phase<pg8::EpiColScale>(ring, g, S, E); } while (0)

    if (EN(2) && IN(PH_MQ)) {
        if (c0 < G / 2) FOLD_MQ(0, c0, G / 2); else FOLD_VW(0, c0 - G / 2, G - G / 2);
    } SEAM(PH_MQ);

    for (int l = 0; l < DEPTH; ++l) {
        const int pb = PH_L0 + l * PH_PER_LAYER;
        unsigned char* wl = ws + oq(WS_WL) + (size_t)l * WL_SIZE;
        if (EN(3) && IN(pb + 0)) {
            pg8::Gemm g{(const bf16_t*)(ws + oq(WS_HB)), (const bf16_t*)(wl + WL_WIN), DM, DM, DM}; pg8::Sched S; S.init_plain(MROWS / 256, INC / 256, G, c0, DM, DM);
            pg8::EpiZ E{(bf16_t*)(ws + oq(WS_ZP)), (bf16_t*)(ws + oq(WS_Q)), (bf16_t*)(ws + oq(WS_KK)), (bf16_t*)(ws + oq(WS_V)), (bf16_t*)(ws + oq(WS_OG)), (bf16_t*)(ws + oq(WS_GA)), (bf16_t*)(ws + oq(WS_GB)),
                        (float*)(ws + oq(WS_G)), (const float*)(ws + oq(WS_SS)), (const float*)(ws + oq(WS_LB)) + l * HDIM};
            S.i1 = 4;
            pg8::gemm_phase<pg8::EpiZ, true, true>(ring, g, S, E);
        } SEAM(pb + 0);
        if (EN(4) && IN(pb + 1)) { p_pool(F); p_hgrn_pre(F); } SEAM(pb + 1);
        if (EN(5) && IN(pb + 2)) { p_hgrn_scan(F); } SEAM(pb + 2);
        if (EN(6) && IN(pb + 3)) {
            if (c0 < G / 2) {
                pg8::Gemm g{(const bf16_t*)(ws + oq(WS_POOLED)), (const bf16_t*)(wl + WL_WG), PD, 256, 256}; pg8::Sched S;
                S.init(MROWS / 256, 4, G / 2, c0, (long)256 * PD * 2, 256 * 2, 0, 0, 0, (long)256 * 256 * 2);
                pg8::EpiColScale E{(bf16_t*)(ws + oq(WS_AB)), DM, g_(F.in[4]) + l * PD, 0};
                pg8::gemm_phase<pg8::EpiColScale>(ring, g, S, E);
                {
                    pg8::Gemm g2{(const bf16_t*)(ws + oq(WS_HB)), (const bf16_t*)(wl + WL_WIN), DM, DM, DM}; pg8::Sched S2; S2.init_plain(MROWS / 256, INC / 256, G, c0, DM, DM); S2.i0 = 4;
                    pg8::EpiZ E2{(bf16_t*)(ws + oq(WS_ZP)), (bf16_t*)(ws + oq(WS_Q)), (bf16_t*)(ws + oq(WS_KK)), (bf16_t*)(ws + oq(WS_V)), (bf16_t*)(ws + oq(WS_OG)), (bf16_t*)(ws + oq(WS_GA)), (bf16_t*)(ws + oq(WS_GB)),
                                 (float*)(ws + oq(WS_G)), (const float*)(ws + oq(WS_SS)), (const float*)(ws + oq(WS_LB)) + l * HDIM};
                    pg8::gemm_phase<pg8::EpiZ, true, true>(ring, g2, S2, E2); }
            } else {
                p_hgrn_norm(F, l, c0 - G / 2, G - G / 2);
                if (l == 0) p_cvt_slot(F, 0, CV_L0_LATE_LO, CV_L0_LATE_HI - CV_L0_LATE_LO, c0 - G / 2, G - G / 2);
                if (l + 1 < DEPTH) p_cvt_slot(F, l + 1, 0, CV_N1, c0 - G / 2, G - G / 2); }
        } SEAM(pb + 3);
        if (EN(7) && IN(pb + 4)) {
            pg8::Gemm g{(const bf16_t*)(ws + oq(WS_AB)), (const bf16_t*)(wl + WL_WBR), DM, DM, DM}; pg8::Sched S; S.init_plain(MROWS / 256, DM / 256, G, c0, DM, DM);
            pg8::EpiBranch E{(bf16_t*)(ws + oq(WS_MERGED)), (const bf16_t*)(ws + oq(WS_GA)), (const bf16_t*)(ws + oq(WS_GB))};
            pg8::gemm_phase<pg8::EpiBranch>(ring, g, S, E);
        } SEAM(pb + 4);
        if (EN(8) && IN(pb + 5)) {
            pg8::Gemm g{(const bf16_t*)(ws + oq(WS_MERGED)), (const bf16_t*)(wl + WL_WMIX), DM, DM, DM}; pg8::Sched S; S.init_plain(MROWS / 256, DM / 256, G, c0, DM, DM);
            pg8::EpiRes E{(bf16_t*)(ws + oq(WS_HB)), (float*)(ws + oq(WS_SS))};
            pg8::gemm_phase<pg8::EpiRes, false>(ring, g, S, E);
        } SEAM(pb + 5);
        if (EN(9) && IN(pb + 6)) {
            pg8::Gemm g{(const bf16_t*)(ws + oq(WS_HB)), (const bf16_t*)(ws + oq(WS_MQ)) + (size_t)l * NB * XH * MEML * DM, DM, DM, DM}; pg8::Sched S;
            S.init(MROWS / 256, XH, G, c0, (long)256 * DM * 2, 0, 0, (long)XH * MEML * DM * 2, 3, (long)MEML * DM * 2);
            pg8::EpiSoftmax E{(bf16_t*)(ws + oq(WS_P)), XH * MEML, (const float*)(ws + oq(WS_SS)), 0.044194173824159216f};
            pg8::gemm_phase<pg8::EpiSoftmax, false, true>(ring, g, S, E);
            if (l + 1 < DEPTH && c0 >= G / 2) {
                FOLD_MQ(l + 1, c0 - G / 2, G - G / 2); FOLD_VW(l + 1, c0 - G / 2, G - G / 2);
                p_cvt_slot(F, l + 1, CV_N1, CV_N3, c0 - G / 2, G - G / 2); }
        } SEAM(pb + 6);
        if (EN(10) && IN(pb + 7)) {
            pg8::Gemm g{(const bf16_t*)(ws + oq(WS_P)), (const bf16_t*)(ws + oq(WS_VW)) + (size_t)l * NB * DM * XH * MEML, XH * MEML, XH * MEML, XH * MEML}; pg8::Sched S;
            S.init(MROWS / 256, DM / 256, G, c0, (long)256 * XH * MEML * 2, 0, 0, (long)DM * XH * MEML * 2, 3, (long)256 * XH * MEML * 2);
            pg8::EpiRes E{(bf16_t*)(ws + oq(WS_HB)), (float*)(ws + oq(WS_SS))};
            pg8::gemm_phase<pg8::EpiRes, false>(ring, g, S, E);
        } SEAM(pb + 7);
        if (EN(11) && IN(pb + 8)) {
            pg8::Gemm g{(const bf16_t*)(ws + oq(WS_HB)), (const bf16_t*)(wl + WL_WFI), DM, DM, DM}; pg8::Sched S; S.init_plain(MROWS / 256, 2 * DFF / 256, G, c0, DM, DM);
            pg8::EpiFfn E{(bf16_t*)(ws + oq(WS_ACT)), (const float*)(ws + oq(WS_SS))};
            pg8::gemm_phase<pg8::EpiFfn, true, true>(ring, g, S, E);
            if (l + 1 < DEPTH && c0 >= G / 2) p_cvt_slot(F, l + 1, CV_N1 + CV_N3, CV_N2, c0 - G / 2, G - G / 2);
        } SEAM(pb + 8);
        if (EN(12) && IN(pb + 9)) {
            pg8::Gemm g{(const bf16_t*)(ws + oq(WS_ACT)), (const bf16_t*)(wl + WL_WFO), DFF, DFF, DFF}; pg8::Sched S; S.init_plain(MROWS / 256, DM / 256, G, c0, DFF, DFF);
            pg8::EpiRes E{(bf16_t*)(ws + oq(WS_HB)), (float*)(ws + oq(WS_SS))};
            pg8::gemm_phase<pg8::EpiRes, false>(ring, g, S, E);
        } SEAM(pb + 9);
    }
    if (EN(13) && IN(PH_FINAL)) { p_final(F); }
#ifdef PROBE_X
    if (IN(N_PHASES + 0)) { p_pool(F); }
    if (IN(N_PHASES + 1)) { p_hgrn_scan(F); }
    if (IN(N_PHASES + 3)) { p_hgrn_pre(F); }
    if (IN(N_PHASES + 4)) { if (c0 >= G / 2) p_cvt_slot(F, 1, 0, 8192, c0 - G / 2, G - G / 2); }
    if (IN(N_PHASES + 5)) { p_cvt_slot(F, 1, 0, 16384, c0, G); }
    if (IN(N_PHASES + 2)) {
        pg8::Gemm g{(const bf16_t*)(ws + oq(WS_HB)), (const bf16_t*)(ws + oq(WS_WL) + WL_WIN), DM, DM, DM}; pg8::Sched S; S.init_plain(MROWS / 256, INC / 256, G, c0, DM, DM);
        pg8::EpiColScale E{(bf16_t*)(ws + oq(WS_ZP)), INC, nullptr}; pg8::gemm_phase<pg8::EpiColScale>(ring, g, S, E); }
#endif
#undef FOLD_MQ
#undef FOLD_VW
#undef IN
#undef SEAM
}

extern "C" void kernel_launch(void* const* d_in, const int* in_sizes, int n_in, void* d_out, int out_size, void* d_ws, size_t ws_size, hipStream_t stream) {
    static int grid = 0;
    if (grid == 0) {
        if (n_in != 20 || out_size != MROWS * DM || ws_size < WS_END) { fprintf(stderr, "kernel_launch: unexpected problem (n_in %d, out %d, ws %zu < %zu)\n", n_in, out_size, ws_size, (size_t)WS_END); grid = -1; return; }
        if (hipFuncSetAttribute((const void*)mk_fwd, hipFuncAttributeMaxDynamicSharedMemorySize, LDS_BYTES) != hipSuccess) { fprintf(stderr, "kernel_launch: hipFuncSetAttribute failed\n"); grid = -1; return; }
        int per_cu = 0;
        if (hipOccupancyMaxActiveBlocksPerMultiprocessor(&per_cu, (const void*)mk_fwd, NWAVES * 64, LDS_BYTES) != hipSuccess || per_cu < 1) fprintf(stderr, "kernel_launch: occupancy query reports %d\n", per_cu);
        (void)hipGetLastError();
        grid = 256;
    }
    if (grid < 0) return;
    (void)hipMemsetAsync((char*)d_ws + WS_CTL, 0, CTL_ZERO_BYTES, stream);
    Args a{};
    for (int i = 0; i < 20; ++i) a.in[i] = (const float*)d_in[i];
    a.out = (float*)d_out; a.ws = (unsigned char*)d_ws;
#if MK_PER_PHASE
    for (int p = 0; p < N_PHASES; ++p) { a.lo = p; a.hi = p + 1; hipLaunchKernelGGL(mk_fwd, dim3(grid), dim3(NWAVES * 64), LDS_BYTES, stream, a); }
#else
    a.lo = 0; a.hi = N_PHASES; hipLaunchKernelGGL(mk_fwd, dim3(grid), dim3(NWAVES * 64), LDS_BYTES, stream, a);
#endif
#ifdef PROBE_X
    for (int l = 0; l < DEPTH; ++l) { const int p = (PROBE_X < 0) ? (-PROBE_X - 1) : (PROBE_X >= 200 ? PH_L0 + 3 * PH_PER_LAYER + PROBE_X - 200 : (PROBE_X >= 100 ? N_PHASES + PROBE_X - 100 : PH_L0 + l * PH_PER_LAYER + PROBE_X)); a.lo = p; a.hi = p + 1;
        hipLaunchKernelGGL(mk_fwd, dim3(grid), dim3(NWAVES * 64), LDS_BYTES, stream, a); }
#endif
}
```

```cpp
#include <hip/hip_runtime.h>
#include <cstdio>
#include <cstdint>

#ifndef MK_PER_PHASE
#define MK_PER_PHASE 0
#endif

#define LAS __attribute__((address_space(3)))
#define GAS __attribute__((address_space(1)))
typedef unsigned short bf16_t;
typedef short bf16x8 __attribute__((ext_vector_type(8)));
typedef float f32x4 __attribute__((ext_vector_type(4)));
typedef unsigned u32x4 __attribute__((ext_vector_type(4)));
typedef unsigned u32x2 __attribute__((ext_vector_type(2)));

constexpr int DM = 2048, NB = 4, SEQ = 2048, DEPTH = 4, MEML = 256;
constexpr int MROWS = NB * SEQ;
constexpr int MEMROWS = NB * MEML;
constexpr int PD = 1024, HDIM = 1024, XH = 4, XHD = 512, DFF = 5632, INC = 9216;
constexpr float EPS = 1e-6f;
constexpr float LOG2E = 1.4426950408889634f;

typedef __bf16 bf16x2_t __attribute__((ext_vector_type(2)));
typedef float f32x2_t __attribute__((ext_vector_type(2)));
__device__ __forceinline__ unsigned cvt_pk_bf16(float lo, float hi) { const f32x2_t v = {lo, hi}; const bf16x2_t r = __builtin_convertvector(v, bf16x2_t); return __builtin_bit_cast(unsigned, r); }
__device__ __forceinline__ float bf_lo(unsigned w) { return __uint_as_float(w << 16); }
__device__ __forceinline__ float bf_hi(unsigned w) { return __uint_as_float(w & 0xffff0000u); }
__device__ __forceinline__ float bf2f(bf16_t h) { return __uint_as_float(((unsigned)h) << 16); }
__device__ __forceinline__ bf16_t f2bf(float f) { return (bf16_t)(cvt_pk_bf16(f, 0.f) & 0xffffu); }
__device__ __forceinline__ float ex2(float x) { return __builtin_amdgcn_exp2f(x); }
__device__ __forceinline__ float rcpf_(float x) { return __builtin_amdgcn_rcpf(x); }
__device__ __forceinline__ float sigm(float z) { return rcpf_(1.0f + ex2(-z * LOG2E)); }
__device__ __forceinline__ void st_bf16x8(bf16_t* p, const f32x4 a, const f32x4 b) {
    u32x4 w; w.x = cvt_pk_bf16(a[0], a[1]); w.y = cvt_pk_bf16(a[2], a[3]); w.z = cvt_pk_bf16(b[0], b[1]); w.w = cvt_pk_bf16(b[2], b[3]);
    *(u32x4*)p = w;
}
__device__ __forceinline__ void ld_bf16x8(const bf16_t* p, f32x4& a, f32x4& b) {
    const u32x4 w = *(const u32x4*)p;
    a = (f32x4){bf_lo(w.x), bf_hi(w.x), bf_lo(w.y), bf_hi(w.y)}; b = (f32x4){bf_lo(w.z), bf_hi(w.z), bf_lo(w.w), bf_hi(w.w)};
}

namespace pg8 {
constexpr int BM = 256, BK = 64, HALF = 128, HTB = HALF * BK * 2, STAGE_BYTES = 8 * HTB, NXCD = 8, WGM = 8;
__host__ __device__ __forceinline__ int lds_byte(int r, int c) { const int st = (r >> 4) * 2 + (c >> 5), rr = r & 15, cc = c & 31, ob = rr * 64 + cc * 2; return st * 1024 + (ob ^ (((ob >> 9) & 1) << 5)); }
__host__ __device__ __forceinline__ void stage_rc(int b, int& R, int& C) { const int st = b / 1024, sb = b % 1024, swz = sb ^ (((sb >> 9) & 1) << 5); R = (st >> 1) * 16 + swz / 64; C = (st & 1) * 32 + (swz % 64) / 2; }
__host__ __device__ __forceinline__ int perm32(int rho) { const int n = rho >> 4, i = rho & 15; return 8 * (i >> 2) + 4 * n + (i & 3); }

constexpr int RSTD_OFF = 131072, RSTD_UNITS = 6;
struct Unit { int pm, pn; long aoff, boff; };
struct Gemm { const bf16_t* A; const bf16_t* Bt; int lda, ldb, K; };

struct Sched {
    int nM, nN, nwg, G, c, a_sh, b_sh, mode, i0, i1; long a_pm, a_pn, b_pm, b_pn;
    __device__ __forceinline__ void init(int nM_, int nN_, int G_, int c_, long apm, long apn, int ash, long bpm, int bsh, long bpn) {
        nM = nM_; nN = nN_; nwg = nM * nN; G = G_; c = c_; mode = 0; i0 = 0; i1 = 1 << 20; a_pm = apm; a_pn = apn; a_sh = ash; b_pm = bpm; b_sh = bsh; b_pn = bpn; }
    __device__ __forceinline__ void init_plain(int nM_, int nN_, int G_, int c_, int lda, int ldb) { init(nM_, nN_, G_, c_, (long)BM * lda * 2, 0, 0, 0, 0, (long)BM * ldb * 2); }
    __device__ __forceinline__ bool next(int i, Unit& u) const {
        if (i + i0 >= i1) return false;
        const long L = (long)(i + i0) * G + c; if (L >= nwg) return false;
        int wgid = (int)L; { const int q = nwg / NXCD, r = nwg % NXCD, xcd = wgid % NXCD, off = wgid / NXCD; wgid = (xcd < r ? xcd * (q + 1) : r * (q + 1) + (xcd - r) * q) + off; }
        const int nig = WGM * nN, gid = wgid / nig, fm = gid * WGM, gsz = (nM - fm) < WGM ? (nM - fm) : WGM;
        u.pm = fm + ((wgid % nig) % gsz); u.pn = (wgid % nig) / gsz;
        u.aoff = (long)u.pm * a_pm + (long)(u.pn >> a_sh) * a_pn; u.boff = (long)(u.pm >> b_sh) * b_pm + (long)u.pn * b_pn;
        if (mode == 1) {
            u.aoff = (long)(u.pm >> 2) * (256L * 16384 * 2) + (long)(u.pm & 3) * 1024; u.boff = (long)(u.pm & 3) * 1024 + (long)u.pn * (256L * 2048 * 2); }
        else if (mode == 2) {
            u.aoff = (long)(u.pm & 7) * (256L * 2048 * 2) + (long)u.pn * 1024; u.boff = (long)(u.pm >> 3) * (256L * 16384 * 2) + (long)u.pn * 1024; }
        return true;
    }
};

template <class Epi, bool ALIGN_EPI = true>
__device__ __forceinline__ void gemm_phase(LAS unsigned char* lds, const Gemm g, const Sched& S, const Epi& E) {
    int tid = threadIdx.x; asm volatile("" : "+v"(tid));
    const int wid = __builtin_amdgcn_readfirstlane(tid >> 6), lane = tid & 63, wr = wid >> 2, wc = wid & 3, fr = lane & 15, fq = lane >> 4;
    int K = g.K; asm volatile("" : "+s"(K));
    const int nt = K / BK;
    unsigned voffA[2], voffB[2];
#pragma unroll
    for (int i = 0; i < 2; ++i) { int R, C; stage_rc(tid * 16 + i * 8192, R, C); const int Rb = (R & ~31) + perm32(R & 31);
        voffA[i] = (unsigned)(R * g.lda + C) * 2u; voffB[i] = (unsigned)(Rb * g.ldb + C) * 2u; }
    const size_t kstep = (size_t)(BK * 2);
    const size_t hstepA = (size_t)HALF * g.lda * 2, hstepB = (size_t)HALF * g.ldb * 2;
    const unsigned ldsw = (unsigned)wid * 1024u;
    const int aoff = lds_byte(wr * 64 + fr, fq * 8), boff = lds_byte(wc * 32 + fr, fq * 8);
#define PG8_SA(b, h) (((b) * 2 + (h)) * HTB)
#define PG8_SB(b, h) ((4 + (b) * 2 + (h)) * HTB)
#define PG8_STAGE(bufoff, gbase, voff) do { _Pragma("unroll") for (int _i = 0; _i < 2; ++_i) \
        __builtin_amdgcn_global_load_lds((const unsigned*)((const char*)(gbase) + (voff)[_i]), (LAS unsigned*)(lds + (bufoff) + ldsw + _i * 8192), 16, 0, 0); } while (0)
#define PG8_LDA(dst, b, h) do { _Pragma("unroll") for (int m = 0; m < 4; ++m) _Pragma("unroll") for (int k = 0; k < 2; ++k) dst[m][k] = *(const LAS bf16x8*)(lds + PG8_SA(b, h) + aoff + m * 2048 + k * 1024); } while (0)
#define PG8_LDB(dst, b, h) do { _Pragma("unroll") for (int n = 0; n < 2; ++n) _Pragma("unroll") for (int k = 0; k < 2; ++k) dst[n][k] = *(const LAS bf16x8*)(lds + PG8_SB(b, h) + boff + n * 2048 + k * 1024); } while (0)
#define PG8_MMA(ai, bj, At, Bt) do { __builtin_amdgcn_s_setprio(1); _Pragma("unroll") for (int m = 0; m < 4; ++m) _Pragma("unroll") for (int n = 0; n < 2; ++n) _Pragma("unroll") for (int k = 0; k < 2; ++k) \
        acc[ai][bj][m][n] = __builtin_amdgcn_mfma_f32_16x16x32_bf16(Bt[n][k], At[m][k], acc[ai][bj][m][n], 0, 0, 0); __builtin_amdgcn_s_setprio(0); } while (0)
#define PG8_WAIT_V(n) asm volatile("s_waitcnt vmcnt(" #n ")" ::: "memory")
#define PG8_WAIT_L(n) asm volatile("s_waitcnt lgkmcnt(" #n ")" ::: "memory")
#define PG8_BAR __builtin_amdgcn_s_barrier()
#define PG8_WAIT_RELAX(flag, n) asm volatile("s_cmp_eq_u32 %0, 0\n\ts_cbranch_scc1 .Lrw%=\n\ts_waitcnt vmcnt(8)\n.Lrw%=:\n\ts_waitcnt vmcnt(%1)" :: "s"(flag), "n"(n) : "scc", "memory")
#define PG8_SCHED __builtin_amdgcn_sched_barrier(0)
    Unit cur, nxt; int ui = 0;
    if (!S.next(0, cur)) return;
    if constexpr (Epi::USES_RSTD) {
        LAS float* T = (LAS float*)(lds + RSTD_OFF);
#pragma unroll
        for (int k = 0; k < RSTD_UNITS * 256 / 512; ++k) { const int idx = tid + 512 * k; Unit uu;
            if (S.next(idx >> 8, uu)) { const float* sp = E.SS + uu.pm * BM + (idx & 255); float ssum = 0.f;
#pragma unroll
                for (int j = 0; j < 8; ++j) ssum += sp[(size_t)j * MROWS];
                T[idx] = __builtin_amdgcn_rsqf(ssum * (1.0f / DM) + EPS); } }
        asm volatile("s_waitcnt lgkmcnt(0)" ::: "memory"); __builtin_amdgcn_s_barrier(); asm volatile("" ::: "memory");
    }
    f32x4 acc[2][2][4][2];
#pragma unroll
    for (int a = 0; a < 2; ++a)
#pragma unroll
        for (int b = 0; b < 2; ++b)
#pragma unroll
            for (int m = 0; m < 4; ++m)
#pragma unroll
                for (int n = 0; n < 2; ++n) acc[a][b][m][n] = (f32x4){0.f, 0.f, 0.f, 0.f};
    bf16x8 At[4][2], B0[2][2], B1[2][2];
    const char* cA = (const char*)g.A + cur.aoff; const char* cB = (const char*)g.Bt + cur.boff;
    PG8_STAGE(PG8_SB(0, 0), cB, voffB); PG8_STAGE(PG8_SB(0, 1), cB + hstepB, voffB); PG8_STAGE(PG8_SA(0, 0), cA, voffA); PG8_STAGE(PG8_SA(0, 1), cA + hstepA, voffA);
    if (wr == 1) PG8_BAR;
    PG8_WAIT_V(2); PG8_BAR;
    PG8_STAGE(PG8_SB(1, 0), cB + kstep, voffB); PG8_STAGE(PG8_SA(1, 0), cA + kstep, voffA); PG8_STAGE(PG8_SB(1, 1), cB + hstepB + kstep, voffB);
    PG8_WAIT_V(6); PG8_BAR;
    for (;;) {
        const bool has_next = S.next(ui + 1, nxt);
        const char* nA = has_next ? (const char*)g.A + nxt.aoff : cA; const char* nB = has_next ? (const char*)g.Bt + nxt.boff : cB;
        for (int hh = 0; hh < (Epi::HAS_MID ? 2 : 1); ++hh) {
        if constexpr (Epi::HAS_MID) { if (hh == 1) { int le = lane; asm volatile("" : "+v"(le)); E.mid(acc, cur, wr, wc, le & 15, le >> 4); } }
        const int t_lo = Epi::HAS_MID ? hh * (nt >> 1) : 0, t_hi = Epi::HAS_MID ? (hh + 1) * (nt >> 1) : nt;
        for (int t = t_lo; t < t_hi; t += 2) {
            const bool last = (t == nt - 2);
            const char* a1 = cA + (size_t)(t + 1) * kstep;
            const char* a2 = last ? nA : cA + (size_t)(t + 2) * kstep; const char* b2 = last ? nB : cB + (size_t)(t + 2) * kstep;
            const char* a3 = a2 + kstep; const char* b3 = b2 + kstep;
            const int rflag = __builtin_amdgcn_readfirstlane(t | (int)(ui == 0));
            PG8_LDB(B0, 0, 0); PG8_LDB(B1, 0, 1); PG8_SCHED; PG8_LDA(At, 0, 0); PG8_STAGE(PG8_SA(1, 1), a1 + hstepA, voffA);
            if constexpr (Epi::NSTORES > 0) PG8_WAIT_RELAX(rflag, 10 + Epi::NSTORES); else PG8_WAIT_V(8);
            PG8_WAIT_L(0); PG8_BAR; PG8_MMA(0, 0, At, B0); PG8_MMA(0, 1, At, B1); PG8_BAR; PG8_SCHED;
            PG8_LDA(At, 0, 1); PG8_STAGE(PG8_SB(0, 0), b2, voffB); PG8_STAGE(PG8_SB(0, 1), b2 + hstepB, voffB); PG8_STAGE(PG8_SA(0, 0), a2, voffA);
            if constexpr (Epi::NSTORES > 0) PG8_WAIT_RELAX(rflag, 10 + Epi::NSTORES); else PG8_WAIT_V(8);
            PG8_WAIT_L(0); PG8_BAR; PG8_MMA(1, 0, At, B0); PG8_MMA(1, 1, At, B1); PG8_BAR; PG8_SCHED;
            PG8_LDB(B0, 1, 0); PG8_LDB(B1, 1, 1); PG8_SCHED; PG8_LDA(At, 1, 0); PG8_STAGE(PG8_SA(0, 1), a2 + hstepA, voffA);
            if constexpr (Epi::NSTORES > 0) PG8_WAIT_RELAX(rflag, 10 + Epi::NSTORES); else PG8_WAIT_V(8);
            PG8_WAIT_L(0); PG8_BAR; PG8_MMA(0, 0, At, B0); PG8_MMA(0, 1, At, B1); PG8_BAR; PG8_SCHED;
            PG8_LDA(At, 1, 1); PG8_STAGE(PG8_SB(1, 0), b3, voffB); PG8_STAGE(PG8_SB(1, 1), b3 + hstepB, voffB); PG8_STAGE(PG8_SA(1, 0), a3, voffA);
            PG8_WAIT_V(8); PG8_WAIT_L(0); PG8_BAR; PG8_MMA(1, 0, At, B0); PG8_MMA(1, 1, At, B1); PG8_BAR; PG8_SCHED;
        }
        }
        if constexpr (Epi::NSTORES > 0) PG8_STAGE(PG8_SA(1, 1), nA + kstep + hstepA, voffA);
        if constexpr (ALIGN_EPI) { if (wr == 0) PG8_BAR; }
        if constexpr (!Epi::AFTER_DRAIN) { int le = lane; asm volatile("" : "+v"(le));
            E(acc, cur, wr, wc, le & 15, le >> 4, ui, lds); }
        if (!has_next) break;
#pragma unroll
        for (int a = 0; a < 2; ++a)
#pragma unroll
            for (int b = 0; b < 2; ++b)
#pragma unroll
                for (int m = 0; m < 4; ++m)
#pragma unroll
                    for (int n = 0; n < 2; ++n) acc[a][b][m][n] = (f32x4){0.f, 0.f, 0.f, 0.f};
        cur = nxt; cA = nA; cB = nB; ++ui;
        if constexpr (ALIGN_EPI) { if (wr == 1) PG8_BAR; }
    }
    PG8_WAIT_V(0);
    if constexpr (!ALIGN_EPI) { if (wr == 0) PG8_BAR; }
    PG8_BAR;
    if constexpr (Epi::AFTER_DRAIN) { int le = lane; asm volatile("" : "+v"(le)); E.fused(acc, cur, wr, wc, le & 15, le >> 4, lds, wid, le); }
#undef PG8_SA
#undef PG8_SB
#undef PG8_STAGE
#undef PG8_LDA
#undef PG8_LDB
#undef PG8_MMA
#undef PG8_WAIT_V
#undef PG8_WAIT_L
#undef PG8_BAR
#undef PG8_SCHED
}

#define ROWG(base, u, ai, m, wr, ld, esz) ((char*)(base) + (size_t)((u).pm * BM + (ai) * HALF + (wr) * 64 + (m) * 16) * (size_t)(ld) * (esz))
__device__ __forceinline__ void load_rstd(const float* SS, const Unit& u, int wr, int fr, int fq, float (&rs)[2][4]) {
    const unsigned loff = (unsigned)((2 * fq) * MROWS + fr) * 4u;
#pragma unroll
    for (int ai = 0; ai < 2; ++ai)
#pragma unroll
        for (int m = 0; m < 4; ++m) { const char* sb = (const char*)(SS + (u.pm * BM + ai * HALF + wr * 64 + m * 16)); const char* sb2 = sb + (size_t)MROWS * 4;
            float s = *(const float*)(sb + loff) + *(const float*)(sb2 + loff);
            s += __shfl_xor(s, 16); s += __shfl_xor(s, 32);
            rs[ai][m] = __builtin_amdgcn_rsqf(s * (1.0f / DM) + EPS); }
}

__device__ __forceinline__ void read_rstd(LAS unsigned char* lds, int ui, int wr, int fr, float (&rs)[2][4]) {
    const LAS float* T = (const LAS float*)(lds + RSTD_OFF) + ui * 256 + wr * 64 + fr;
#pragma unroll
    for (int ai = 0; ai < 2; ++ai)
#pragma unroll
        for (int m = 0; m < 4; ++m) rs[ai][m] = T[ai * HALF + m * 16];
}
__host__ __device__ __forceinline__ int zperm(int t) { return (t == 16 || t == 17) ? t + 4 : ((t == 20 || t == 21) ? t - 4 : t); }
struct EpiZ {
    static constexpr bool USES_RSTD = true, AFTER_DRAIN = false, HAS_MID = false; static constexpr int NSTORES = 16;
    bf16_t *ZP, *Q, *KK, *V, *OG, *GA, *GB; float* G; const float* SS; const float* LB;
    __device__ __forceinline__ void operator()(const f32x4 (&acc)[2][2][4][2], const Unit& u, int wr, int wc, int fr, int fq, int ui, LAS unsigned char* lds) const {
        const int cl = wc * 32 + 8 * fq; const int pn = zperm(u.pn);
        float rs[2][4]; read_rstd(lds, ui, wr, fr, rs);
        if (pn >= 8 && pn < 12) {
            const int cb = (pn - 8) * 256 + cl;
            const unsigned lo4 = (unsigned)(fr * HDIM + cb) * 4u, lo2 = (unsigned)(fr * HDIM + cb) * 2u;
#pragma unroll
            for (int bj = 0; bj < 2; ++bj) {
                const f32x4 l0 = *(const f32x4*)(LB + cb + bj * HALF), l1 = *(const f32x4*)(LB + cb + bj * HALF + 4);
#pragma unroll
                for (int ai = 0; ai < 2; ++ai)
#pragma unroll
                    for (int m = 0; m < 4; ++m) { const float r = rs[ai][m];
                        f32x4 gg[2], kk[2];
#pragma unroll
                        for (int n = 0; n < 2; ++n) { const f32x4 lb = n ? l1 : l0;
#pragma unroll
                            for (int j = 0; j < 4; ++j) { float z = acc[ai][bj][m][n][j] * r; z = fminf(fmaxf(z, -80.f), 80.f);
                                const float e = ex2(-z * LOG2E), sg = rcpf_(1.0f + e), om = 1.0f - lb[j];
                                gg[n][j] = __builtin_amdgcn_logf(lb[j] + om * sg); kk[n][j] = om * e * sg; } }
                        char* gb = ROWG(G, u, ai, m, wr, HDIM, 4) + bj * HALF * 4; char* kb = ROWG(KK, u, ai, m, wr, HDIM, 2) + bj * HALF * 2;
                        *(f32x4*)(gb + lo4) = gg[0]; *(f32x4*)(gb + lo4 + 16) = gg[1];
                        st_bf16x8((bf16_t*)(kb + lo2), kk[0], kk[1]); } }
        } else {
            bf16_t* dst; int ld, cb, ty;
            if (pn < 4) { dst = ZP; ld = PD; cb = pn * 256; ty = 0; }
            else if (pn < 8) { dst = Q; ld = HDIM; cb = (pn - 4) * 256; ty = 1; }
            else if (pn < 16) { dst = V; ld = HDIM; cb = (pn - 12) * 256; ty = 0; }
            else if (pn < 20) { dst = OG; ld = HDIM; cb = (pn - 16) * 256; ty = 1; }
            else if (pn < 28) { dst = GA; ld = DM; cb = (pn - 20) * 256; ty = 2; }
            else { dst = GB; ld = DM; cb = (pn - 28) * 256; ty = 2; }
            const unsigned loff = (unsigned)(fr * ld + cb + cl) * 2u;
#define EPZ_LOOP(BODY) _Pragma("unroll") for (int ai = 0; ai < 2; ++ai) _Pragma("unroll") for (int m = 0; m < 4; ++m) { const float r = rs[ai][m]; const float rn = -r * LOG2E; (void)rn; char* rb = ROWG(dst, u, ai, m, wr, ld, 2); \
                _Pragma("unroll") for (int bj = 0; bj < 2; ++bj) { f32x4 v[2]; _Pragma("unroll") for (int n = 0; n < 2; ++n) { const f32x4 a = acc[ai][bj][m][n]; BODY } \
                    st_bf16x8((bf16_t*)(rb + loff + bj * HALF * 2), v[0], v[1]); } }
            if (ty == 0) { EPZ_LOOP( v[n] = a * r; ) }
            else if (ty == 1) { EPZ_LOOP( const f32x4 t = a * rn; f32x4 e; e[0] = ex2(t[0]); e[1] = ex2(t[1]); e[2] = ex2(t[2]); e[3] = ex2(t[3]); const f32x4 d = e + 1.0f;
                                          f32x4 sg; sg[0] = rcpf_(d[0]); sg[1] = rcpf_(d[1]); sg[2] = rcpf_(d[2]); sg[3] = rcpf_(d[3]); v[n] = (a * r) * sg; ) }
            else { EPZ_LOOP( const f32x4 t = a * rn; f32x4 e; e[0] = ex2(t[0]); e[1] = ex2(t[1]); e[2] = ex2(t[2]); e[3] = ex2(t[3]); const f32x4 d = e + 1.0f;
                             f32x4 sg; sg[0] = rcpf_(d[0]); sg[1] = rcpf_(d[1]); sg[2] = rcpf_(d[2]); sg[3] = rcpf_(d[3]); v[n] = sg; ) }
#undef EPZ_LOOP
        }
    }
};
struct EpiRowScale {
    static constexpr bool USES_RSTD = false, AFTER_DRAIN = false, HAS_MID = false; static constexpr int NSTORES = 16;
    bf16_t* O; int ldc; const float* SS; const float* RS; float cst;
    __device__ __forceinline__ void operator()(const f32x4 (&acc)[2][2][4][2], const Unit& u, int wr, int wc, int fr, int fq, int ui, LAS unsigned char* lds) const {
        const unsigned loff = (unsigned)(fr * ldc + u.pn * BM + wc * 32 + 8 * fq) * 2u;
        float rs[2][4];
        if (SS) load_rstd(SS, u, wr, fr, fq, rs);
        else {
#pragma unroll
            for (int ai = 0; ai < 2; ++ai)
#pragma unroll
                for (int m = 0; m < 4; ++m) rs[ai][m] = *(const float*)((const char*)(RS + (u.pm * BM + ai * HALF + wr * 64 + m * 16)) + (unsigned)fr * 4u); }
#pragma unroll
        for (int ai = 0; ai < 2; ++ai)
#pragma unroll
            for (int m = 0; m < 4; ++m) { const float r = rs[ai][m] * cst; char* rb = ROWG(O, u, ai, m, wr, ldc, 2);
#pragma unroll
                for (int bj = 0; bj < 2; ++bj) st_bf16x8((bf16_t*)(rb + loff + bj * HALF * 2), acc[ai][bj][m][0] * r, acc[ai][bj][m][1] * r); }
    }
};
struct EpiColScale {
    static constexpr bool USES_RSTD = false, AFTER_DRAIN = false, HAS_MID = false; static constexpr int NSTORES = 16;
    bf16_t* O; int ldc; const float* CS;
    __device__ __forceinline__ void operator()(const f32x4 (&acc)[2][2][4][2], const Unit& u, int wr, int wc, int fr, int fq, int ui, LAS unsigned char* lds) const {
        const int col0 = u.pn * BM + wc * 32 + 8 * fq; const unsigned loff = (unsigned)(fr * ldc + col0) * 2u;
        f32x4 cs[2][2];
#pragma unroll
        for (int bj = 0; bj < 2; ++bj)
#pragma unroll
            for (int n = 0; n < 2; ++n) cs[bj][n] = CS ? *(const f32x4*)(CS + col0 + bj * HALF + 4 * n) : (f32x4){1.f, 1.f, 1.f, 1.f};
#pragma unroll
        for (int ai = 0; ai < 2; ++ai)
#pragma unroll
            for (int m = 0; m < 4; ++m) { char* rb = ROWG(O, u, ai, m, wr, ldc, 2);
#pragma unroll
                for (int bj = 0; bj < 2; ++bj) st_bf16x8((bf16_t*)(rb + loff + bj * HALF * 2), acc[ai][bj][m][0] * cs[bj][0], acc[ai][bj][m][1] * cs[bj][1]); }
    }
};
struct EpiFfn {
    static constexpr bool USES_RSTD = true, AFTER_DRAIN = false, HAS_MID = false; static constexpr int NSTORES = 8;
    bf16_t* ACT; const float* SS;
    __device__ __forceinline__ void operator()(const f32x4 (&acc)[2][2][4][2], const Unit& u, int wr, int wc, int fr, int fq, int ui, LAS unsigned char* lds) const {
        const unsigned loff = (unsigned)(fr * DFF + u.pn * HALF + wc * 32 + 8 * fq) * 2u;
        float rs[2][4]; read_rstd(lds, ui, wr, fr, rs);
#pragma unroll
        for (int ai = 0; ai < 2; ++ai)
#pragma unroll
            for (int m = 0; m < 4; ++m) { const float r = rs[ai][m], rn = -r * LOG2E, rr = r * r; f32x4 v[2]; char* rb = ROWG(ACT, u, ai, m, wr, DFF, 2);
#pragma unroll
                for (int n = 0; n < 2; ++n) { const f32x4 g = acc[ai][0][m][n], up = acc[ai][1][m][n]; const f32x4 t = g * rn;
                    f32x4 e; e[0] = ex2(t[0]); e[1] = ex2(t[1]); e[2] = ex2(t[2]); e[3] = ex2(t[3]); const f32x4 d = e + 1.0f;
                    f32x4 sg; sg[0] = rcpf_(d[0]); sg[1] = rcpf_(d[1]); sg[2] = rcpf_(d[2]); sg[3] = rcpf_(d[3]);
                    v[n] = ((g * up) * rr) * sg; }
                st_bf16x8((bf16_t*)(rb + loff), v[0], v[1]); }
    }
};
struct EpiBranch {
    static constexpr bool USES_RSTD = false, AFTER_DRAIN = false, HAS_MID = true; static constexpr int NSTORES = 0;
    bf16_t* O; const bf16_t* GA; const bf16_t* GB;
    __device__ __forceinline__ void mid(f32x4 (&acc)[2][2][4][2], const Unit& u, int wr, int wc, int fr, int fq) const {
        const unsigned loff = (unsigned)(fr * DM + u.pn * BM + wc * 32 + 8 * fq) * 2u;
#pragma unroll
        for (int ai = 0; ai < 2; ++ai) {
            u32x4 ga[4][2], gb[4][2];
#pragma unroll
            for (int m = 0; m < 4; ++m) { const char* pa = ROWG(GA, u, ai, m, wr, DM, 2); const char* pb = ROWG(GB, u, ai, m, wr, DM, 2);
#pragma unroll
                for (int bj = 0; bj < 2; ++bj) { ga[m][bj] = *(const u32x4*)(pa + loff + bj * HALF * 2); gb[m][bj] = *(const u32x4*)(pb + loff + bj * HALF * 2); } }
#pragma unroll
            for (int m = 0; m < 4; ++m)
#pragma unroll
                for (int bj = 0; bj < 2; ++bj) { const u32x4 a = ga[m][bj], g = gb[m][bj];
                    const f32x4 a0 = {bf_lo(a.x), bf_hi(a.x), bf_lo(a.y), bf_hi(a.y)}, a1 = {bf_lo(a.z), bf_hi(a.z), bf_lo(a.w), bf_hi(a.w)};
                    const f32x4 b0 = {bf_lo(g.x), bf_hi(g.x), bf_lo(g.y), bf_hi(g.y)}, b1 = {bf_lo(g.z), bf_hi(g.z), bf_lo(g.w), bf_hi(g.w)};
#pragma unroll
                    for (int j = 0; j < 4; ++j) { acc[ai][bj][m][0][j] *= a0[j] * rcpf_(b0[j]); acc[ai][bj][m][1][j] *= a1[j] * rcpf_(b1[j]); } }
            asm volatile("" ::: "memory"); }
    }
    __device__ __forceinline__ void operator()(const f32x4 (&acc)[2][2][4][2], const Unit& u, int wr, int wc, int fr, int fq, int ui, LAS unsigned char* lds) const {
        const unsigned loff = (unsigned)(fr * DM + u.pn * BM + wc * 32 + 8 * fq) * 2u;
        u32x4 gb[2][4][2];
#pragma unroll
        for (int ai = 0; ai < 2; ++ai)
#pragma unroll
            for (int m = 0; m < 4; ++m) { const char* pb = ROWG(GB, u, ai, m, wr, DM, 2);
#pragma unroll
                for (int bj = 0; bj < 2; ++bj) gb[ai][m][bj] = *(const u32x4*)(pb + loff + bj * HALF * 2); }
#pragma unroll
        for (int ai = 0; ai < 2; ++ai)
#pragma unroll
            for (int m = 0; m < 4; ++m) { char* ob = ROWG(O, u, ai, m, wr, DM, 2);
#pragma unroll
                for (int bj = 0; bj < 2; ++bj) { const u32x4 g = gb[ai][m][bj];
                    const f32x4 b0 = {bf_lo(g.x), bf_hi(g.x), bf_lo(g.y), bf_hi(g.y)}, b1 = {bf_lo(g.z), bf_hi(g.z), bf_lo(g.w), bf_hi(g.w)};
                    st_bf16x8((bf16_t*)(ob + loff + bj * HALF * 2), acc[ai][bj][m][0] * b0, acc[ai][bj][m][1] * b1); } }
    }
};
struct EpiRes {
    static constexpr bool USES_RSTD = false, AFTER_DRAIN = true, HAS_MID = false; static constexpr int NSTORES = 0;
    bf16_t* HB; float* SS;
    __device__ __forceinline__ void fused(f32x4 (&acc)[2][2][4][2], const Unit& u, int wr, int wc, int fr, int fq, LAS unsigned char* lds, int wid, int lane) const {
        LAS float* P = (LAS float*)lds;
        const unsigned lo2 = (unsigned)(fr * DM + u.pn * BM + wc * 32 + 8 * fq) * 2u;
        u32x4 hv[2][4][2];
#pragma unroll
        for (int ai = 0; ai < 2; ++ai)
#pragma unroll
            for (int m = 0; m < 4; ++m) { const char* hb2 = ROWG(HB, u, ai, m, wr, DM, 2);
#pragma unroll
                for (int bj = 0; bj < 2; ++bj) hv[ai][m][bj] = *(const u32x4*)(hb2 + lo2 + bj * HALF * 2); }
#pragma unroll
        for (int ai = 0; ai < 2; ++ai)
#pragma unroll
            for (int m = 0; m < 4; ++m) { const int rl = ai * HALF + wr * 64 + m * 16 + fr; char* hb2 = ROWG(HB, u, ai, m, wr, DM, 2); float s = 0.f;
#pragma unroll
                for (int bj = 0; bj < 2; ++bj) { const u32x4 w = hv[ai][m][bj];
                    const f32x4 h0 = (f32x4){bf_lo(w.x), bf_hi(w.x), bf_lo(w.y), bf_hi(w.y)} + acc[ai][bj][m][0], h1 = (f32x4){bf_lo(w.z), bf_hi(w.z), bf_lo(w.w), bf_hi(w.w)} + acc[ai][bj][m][1];
                    st_bf16x8((bf16_t*)(hb2 + lo2 + bj * HALF * 2), h0, h1);
                    s += (h0[0] * h0[0] + h0[1] * h0[1]) + (h0[2] * h0[2] + h0[3] * h0[3]) + (h1[0] * h1[0] + h1[1] * h1[1]) + (h1[2] * h1[2] + h1[3] * h1[3]); }
                s += __shfl_xor(s, 16); s += __shfl_xor(s, 32);
                if (fq == 0) P[rl * 4 + wc] = s; }
        asm volatile("s_waitcnt lgkmcnt(0)" ::: "memory"); __builtin_amdgcn_s_barrier(); asm volatile("" ::: "memory");
        const int tid = wid * 64 + lane;
        if (tid < 256) { const f32x4 p = *(const LAS f32x4*)(P + tid * 4); SS[(size_t)u.pn * MROWS + u.pm * BM + tid] = (p[0] + p[1]) + (p[2] + p[3]); }
        asm volatile("s_waitcnt lgkmcnt(0)" ::: "memory"); __builtin_amdgcn_s_barrier(); asm volatile("" ::: "memory");
    }
};
struct EpiSoftmax {
    static constexpr bool USES_RSTD = false, AFTER_DRAIN = true, HAS_MID = false; static constexpr int NSTORES = 0;
    bf16_t* P; int ldc; const float* SS; float cst;
    __device__ __forceinline__ void fused(f32x4 (&acc)[2][2][4][2], const Unit& u, int wr, int wc, int fr, int fq, LAS unsigned char* lds, int wid, int lane) const {
        LAS float* X1 = (LAS float*)lds; LAS float* X2 = (LAS float*)(lds + 4096);
        const unsigned loff = (unsigned)(fr * ldc + u.pn * BM + wc * 32 + 8 * fq) * 2u;
        float rs[2][4]; load_rstd(SS, u, wr, fr, fq, rs);
#pragma unroll
        for (int ai = 0; ai < 2; ++ai)
#pragma unroll
            for (int m = 0; m < 4; ++m) { const int rl = ai * HALF + wr * 64 + m * 16 + fr; const float r = rs[ai][m] * cst; float mx = -3.0e38f;
#pragma unroll
                for (int bj = 0; bj < 2; ++bj)
#pragma unroll
                    for (int n = 0; n < 2; ++n)
#pragma unroll
                        for (int j = 0; j < 4; ++j) { const float v = acc[ai][bj][m][n][j] * r; acc[ai][bj][m][n][j] = v; mx = fmaxf(mx, v); }
                mx = fmaxf(mx, __shfl_xor(mx, 16)); mx = fmaxf(mx, __shfl_xor(mx, 32));
                if (fq == 0) X1[rl * 4 + wc] = mx; }
        asm volatile("s_waitcnt lgkmcnt(0)" ::: "memory"); __builtin_amdgcn_s_barrier(); asm volatile("" ::: "memory");
#pragma unroll
        for (int ai = 0; ai < 2; ++ai)
#pragma unroll
            for (int m = 0; m < 4; ++m) { const int rl = ai * HALF + wr * 64 + m * 16 + fr; const f32x4 q = *(const LAS f32x4*)(X1 + rl * 4);
                const float mx = fmaxf(fmaxf(q[0], q[1]), fmaxf(q[2], q[3])) * LOG2E; float s = 0.f;
#pragma unroll
                for (int bj = 0; bj < 2; ++bj)
#pragma unroll
                    for (int n = 0; n < 2; ++n)
#pragma unroll
                        for (int j = 0; j < 4; ++j) { const float e = ex2(acc[ai][bj][m][n][j] * LOG2E - mx); acc[ai][bj][m][n][j] = e; s += e; }
                s += __shfl_xor(s, 16); s += __shfl_xor(s, 32);
                if (fq == 0) X2[rl * 4 + wc] = s; }
        asm volatile("s_waitcnt lgkmcnt(0)" ::: "memory"); __builtin_amdgcn_s_barrier(); asm volatile("" ::: "memory");
#pragma unroll
        for (int ai = 0; ai < 2; ++ai)
#pragma unroll
            for (int m = 0; m < 4; ++m) { const int rl = ai * HALF + wr * 64 + m * 16 + fr; const f32x4 q = *(const LAS f32x4*)(X2 + rl * 4);
                const float inv = 1.0f / ((q[0] + q[1]) + (q[2] + q[3])); char* rb = ROWG(P, u, ai, m, wr, ldc, 2);
#pragma unroll
                for (int bj = 0; bj < 2; ++bj) st_bf16x8((bf16_t*)(rb + loff + bj * HALF * 2), acc[ai][bj][m][0] * inv, acc[ai][bj][m][1] * inv); }
        asm volatile("s_waitcnt lgkmcnt(0)" ::: "memory"); __builtin_amdgcn_s_barrier(); asm volatile("" ::: "memory");
    }
};
}

constexpr size_t MiB = 1u << 20;
constexpr size_t WS_CTL = 0, CTL_ZERO_BYTES = 1 * MiB;
constexpr size_t WS_LB = 1 * MiB;
constexpr size_t WS_RSM = 1 * MiB + 64 * 1024;
constexpr size_t WS_SS = 1 * MiB + 128 * 1024;
constexpr size_t WS_SSQ = 2 * MiB;
constexpr size_t WS_WL = 4 * MiB;
constexpr size_t WL_WIN = 0, WL_WG = 36 * MiB, WL_WBR = 37 * MiB, WL_WMIX = 45 * MiB, WL_WXQ = 53 * MiB, WL_WXO = 61 * MiB, WL_WFI = 69 * MiB, WL_WFO = 113 * MiB, WL_SIZE = 135 * MiB;
constexpr size_t WS_WK = WS_WL + 4 * WL_SIZE;
constexpr size_t WS_WV = WS_WK + 32 * MiB;
constexpr size_t WS_HB = WS_WV + 32 * MiB;
constexpr size_t WS_ZP = WS_HB + 32 * MiB;
constexpr size_t WS_Q = WS_ZP + 16 * MiB;
constexpr size_t WS_KK = WS_Q + 16 * MiB;
constexpr size_t WS_V = WS_KK + 16 * MiB;
constexpr size_t WS_G = WS_V + 16 * MiB;
constexpr size_t WS_OG = WS_G + 32 * MiB;
constexpr size_t WS_GA = WS_OG + 16 * MiB;
constexpr size_t WS_GB = WS_GA + 32 * MiB;
constexpr size_t WS_POOLED = WS_GB + 32 * MiB;
constexpr size_t WS_AB = WS_POOLED + 16 * MiB;
constexpr size_t WS_ORAW = WS_AB + 32 * MiB;
constexpr size_t WS_MERGED = WS_ORAW + 16 * MiB;
constexpr size_t WS_P = WS_MERGED + 32 * MiB;
constexpr size_t WS_ACT = WS_P + 16 * MiB;
constexpr size_t WS_KVB = WS_ACT + 88 * MiB;
constexpr size_t WS_MQ = WS_KVB + 32 * MiB;
constexpr size_t WS_VW = WS_MQ + 64 * MiB;
constexpr size_t WS_MEMB = WS_VW + 64 * MiB;
constexpr size_t WS_HIMG = WS_MEMB + 4 * MiB;
constexpr size_t WS_HVEC = WS_HIMG + 52 * MiB;
constexpr size_t WS_END = WS_HVEC + 2 * MiB;
constexpr int CW_BAR = 4096;

constexpr int RING_BYTES = 131072, LDS_BYTES = 163840, LDSCTL_OFF = LDS_BYTES - 1024, MISC_OFF = LDSCTL_OFF + 320;
constexpr int NWAVES = 8;

#define XB_TMO      128
#define XB_XCNT(j)  (256  + 64 * (j))
#define XB_XSUB(j)  (1280 + 64 * (j))
#define XB_XGEN(j)  (2304 + 64 * (j))
#define XB_TOP      3328
#define XB_TOPGEN   3392
#define XCD_BAR_WORDS 3456
#define XB_SPIN_CAP (1u << 18)
__device__ __forceinline__ unsigned xb_ld(unsigned* p)              { return __hip_atomic_load(p, __ATOMIC_RELAXED, __HIP_MEMORY_SCOPE_AGENT); }
__device__ __forceinline__ unsigned xb_add(unsigned* p, unsigned v) { return __hip_atomic_fetch_add(p, v, __ATOMIC_RELAXED, __HIP_MEMORY_SCOPE_AGENT); }
__device__ __forceinline__ unsigned xb_xcc_id() { return (unsigned)__builtin_amdgcn_s_getreg((3 << 11) | 20) & 0xFu; }
#define XB_SPIN(cond, bar) do { unsigned _sp = 0; while (cond) { __builtin_amdgcn_s_sleep(1); \
    if ((++_sp & 255u) == 0u) { if (xb_ld(&(bar)[XB_TMO])) break; if (_sp > XB_SPIN_CAP) { atomicAdd(&(bar)[XB_TMO], 1u); break; } } } } while (0)
struct XcdBarrier { unsigned* bar; unsigned x; volatile LAS unsigned* st; };
__device__ __forceinline__ XcdBarrier xcd_barrier_post(unsigned* bar, volatile LAS unsigned* st) {
    XcdBarrier b; b.bar = bar; b.x = xb_xcc_id(); b.st = st;
    if (threadIdx.x == 0) (void)xb_add(&bar[XB_XCNT(b.x)], 1u);
    return b;
}
__device__ __forceinline__ void xcd_barrier_complete(unsigned* bar, unsigned x, unsigned& nloc, unsigned& nx) {
    const unsigned G = gridDim.x * gridDim.y * gridDim.z;
    unsigned sum, cnt, mine, sp = 0u;
    for (;;) {
        sum = 0u; cnt = 0u; mine = 0u;
#pragma unroll
        for (unsigned j = 0; j < 16; ++j) { const unsigned c = xb_ld(&bar[XB_XCNT(j)]); sum += c; cnt += (c > 0u) ? 1u : 0u; mine = (j == x) ? c : mine; }
        if (sum == G) break;
        __builtin_amdgcn_s_sleep(1);
        if ((++sp & 255u) == 0u) { if (xb_ld(&bar[XB_TMO])) break; if (sp > XB_SPIN_CAP) { atomicAdd(&bar[XB_TMO], 1u); break; } }
    }
    nloc = mine > 0u ? mine : 1u; nx = cnt > 0u ? cnt : 1u;
}
__device__ __forceinline__ void xcd_barrier(const XcdBarrier& b) {
    asm volatile("s_waitcnt vmcnt(0)" ::: "memory");
    __syncthreads();
    if (threadIdx.x == 0) {
        unsigned* bar = b.bar;
        __builtin_amdgcn_s_waitcnt(0);
        unsigned nloc = b.st[0], nx = b.st[1];
        if (nloc == 0u) { xcd_barrier_complete(bar, b.x, nloc, nx); b.st[0] = nloc; b.st[1] = nx; }
        const unsigned old = xb_add(&bar[XB_XSUB(b.x)], 1u);
        const unsigned gen = old / nloc;
        if (old + 1u == (gen + 1u) * nloc) {
            __builtin_amdgcn_fence(__ATOMIC_RELEASE, "agent");
            asm volatile("s_waitcnt vmcnt(0)" ::: "memory");
            const unsigned og = xb_add(&bar[XB_TOP], 1u);
            const unsigned tg = og / nx;
            if (og + 1u == (tg + 1u) * nx) xb_add(&bar[XB_TOPGEN], 1u);
            else XB_SPIN(xb_ld(&bar[XB_TOPGEN]) == tg, bar);
            __builtin_amdgcn_fence(__ATOMIC_ACQUIRE, "agent");
            xb_add(&bar[XB_XGEN(b.x)], 1u);
            asm volatile("s_waitcnt vmcnt(0)" ::: "memory");
        } else {
            XB_SPIN(xb_ld(&bar[XB_XGEN(b.x)]) == gen, bar);
            __builtin_amdgcn_fence(__ATOMIC_ACQUIRE, "agent");
            asm volatile("s_waitcnt vmcnt(0)" ::: "memory");
        }
    }
    __syncthreads();
}

struct Frame {
    LAS unsigned char* lds;
    int vcu, G;
    const float* const* in; float* out; unsigned char* ws;
};
#define LDS_WAIT() asm volatile("s_waitcnt lgkmcnt(0)" ::: "memory")
__device__ __forceinline__ int opaque_tid() { int t = threadIdx.x; asm volatile("" : "+v"(t)); return t; }
template <class T> __device__ __forceinline__ T* g_(T* p) { return (T*)(GAS T*)p; }
__device__ __forceinline__ size_t oq(size_t c) { asm volatile("" : "+s"(c)); return c; }
#define PHASE_IDS() const int tid = opaque_tid(), lane = tid & 63, wave = __builtin_amdgcn_readfirstlane(tid >> 6); (void)lane; (void)wave
__device__ __forceinline__ float wave_sum(float v) {
#pragma unroll
    for (int o = 1; o < 64; o <<= 1) v += __shfl_xor(v, o);
    return v;
}

constexpr int IT_WIN = 32 * 144, IT_WG = 64, IT_BR = 16 * 32, IT_SQ = 32 * 32, IT_FI = 32 * 176, IT_FO = 88 * 32;
constexpr int IT_LAYER = IT_WIN + IT_WG + 2 * IT_BR + 5 * IT_SQ + IT_FI + IT_FO;
constexpr int CV_N1 = 8096, CV_N3 = 1024, CV_N2 = 8096, CV_SLOT = CV_N1 + CV_N3 + CV_N2;
constexpr int CV_L0_LATE_LO = 2 * IT_SQ + IT_WIN + IT_WG + 2 * IT_BR + IT_SQ, CV_L0_LATE_HI = CV_L0_LATE_LO + IT_FI + IT_FO;
static_assert(CV_SLOT <= IT_LAYER - 2 * IT_SQ, "the K/V weight items (last in a layer) always belong to the prologue");
struct CvtJob { const float* W; const float* gain; bf16_t* WT; int src_ld, dst_ld, k0, n0, dst_col, plain; long dst_row; };
__device__ __forceinline__ void cvt_decode(const float* const* in, unsigned char* ws, int l, int r, CvtJob& j) {
    unsigned char* wl = ws + WS_WL + (size_t)l * WL_SIZE;
    j.gain = nullptr; j.dst_col = 0; j.src_ld = DM; j.dst_ld = DM; j.plain = 0;
    if (r < IT_SQ) { const int kb = r / 32, nb = r % 32; j.W = g_(in[13]) + (size_t)l * DM * DM; j.gain = g_(in[12]) + l * DM; j.WT = (bf16_t*)(wl + WL_WXQ); j.k0 = 64 * kb; j.n0 = 64 * nb; j.dst_row = 0; j.plain = 1; return; } r -= IT_SQ;
    if (r < IT_SQ) { const int kb = r / 32, nb = r % 32; j.W = g_(in[15]) + (size_t)l * DM * DM; j.WT = (bf16_t*)(wl + WL_WXO); j.k0 = 64 * kb; j.n0 = 64 * nb; j.dst_row = 64 * nb; return; } r -= IT_SQ;
    if (r < IT_WIN) { const int kb = r / 144, nb = r % 144; j.W = g_(in[2]) + (size_t)l * DM * INC; j.src_ld = INC; j.gain = g_(in[10]) + l * DM; j.WT = (bf16_t*)(wl + WL_WIN); j.k0 = 64 * kb; j.n0 = 64 * nb; j.dst_row = 256 * pg8::zperm(nb >> 2) + 64 * (nb & 3); return; } r -= IT_WIN;
    if (r < IT_WG) { const int g = r / 16, rr = r % 16, kb = rr / 4, nb = rr % 4; j.W = g_(in[3]) + (size_t)(l * 4 + g) * 256 * 256; j.src_ld = 256; j.WT = (bf16_t*)(wl + WL_WG); j.dst_ld = 256; j.k0 = 64 * kb; j.n0 = 64 * nb; j.dst_row = g * 256 + 64 * nb; return; } r -= IT_WG;
    if (r < IT_BR) { const int kb = r / 32, nb = r % 32; j.W = g_(in[7]) + (size_t)l * PD * DM; j.WT = (bf16_t*)(wl + WL_WBR); j.k0 = 64 * kb; j.n0 = 64 * nb; j.dst_row = 64 * nb; return; } r -= IT_BR;
    if (r < IT_BR) { const int kb = r / 32, nb = r % 32; j.W = g_(in[8]) + (size_t)l * HDIM * DM; j.WT = (bf16_t*)(wl + WL_WBR); j.k0 = 64 * kb; j.n0 = 64 * nb; j.dst_row = 64 * nb; j.dst_col = PD; return; } r -= IT_BR;
    if (r < IT_SQ) { const int kb = r / 32, nb = r % 32; j.W = g_(in[9]) + (size_t)l * DM * DM; j.WT = (bf16_t*)(wl + WL_WMIX); j.k0 = 64 * kb; j.n0 = 64 * nb; j.dst_row = 64 * nb; return; } r -= IT_SQ;
    if (r < IT_FI) { const int kb = r / 176, nb = r % 176, n0 = 64 * nb, s = n0 / DFF, jj = n0 % DFF; j.W = g_(in[17]) + (size_t)l * DM * 2 * DFF; j.src_ld = 2 * DFF; j.gain = g_(in[16]) + l * DM; j.WT = (bf16_t*)(wl + WL_WFI);
        j.k0 = 64 * kb; j.n0 = n0; j.dst_row = 256 * (jj / 128) + 128 * s + (jj % 128); return; } r -= IT_FI;
    if (r < IT_FO) { const int kb = r / 32, nb = r % 32; j.W = g_(in[18]) + (size_t)l * DFF * DM; j.WT = (bf16_t*)(wl + WL_WFO); j.dst_ld = DFF; j.k0 = 64 * kb; j.n0 = 64 * nb; j.dst_row = 64 * nb; return; } r -= IT_FO;
    if (r < IT_SQ) { const int kb = r / 32, nb = r % 32; j.W = g_(in[14]) + (size_t)l * DM * 2 * DM; j.src_ld = 2 * DM; j.gain = g_(in[11]) + l * DM; j.WT = (bf16_t*)(ws + WS_WK); j.k0 = 64 * kb; j.n0 = 64 * nb; j.dst_row = (long)l * DM + 64 * nb; return; } r -= IT_SQ;
    { const int kb = r / 32, nb = r % 32; j.W = g_(in[14]) + (size_t)l * DM * 2 * DM + DM; j.src_ld = 2 * DM; j.gain = g_(in[11]) + l * DM; j.WT = (bf16_t*)(ws + WS_WV); j.k0 = 64 * kb; j.n0 = 64 * nb; j.dst_row = (long)l * DM + 64 * nb; }
}
__device__ __forceinline__ void cvt_load(const CvtJob& j, f32x4 (&v)[16], int lane) {
    const int kr = lane >> 4, n4 = lane & 15;
#pragma unroll
    for (int i = 0; i < 16; ++i) v[i] = __builtin_nontemporal_load((const f32x4*)(j.W + (size_t)(j.k0 + 4 * i + kr) * j.src_ld + j.n0 + 4 * n4));
}
__device__ __forceinline__ void cvt_store(const CvtJob& j, const f32x4 (&v)[16], LAS float* scr, int lane) {
    const int kr = lane >> 4, n4 = lane & 15, c = lane & 3;
    if (j.plain) {
#pragma unroll
        for (int i = 0; i < 16; ++i) { const int k = j.k0 + 4 * i + kr; const float g = j.gain ? j.gain[k] : 1.0f; const f32x4 x = v[i] * g;
            u32x2 w; w.x = cvt_pk_bf16(x[0], x[1]); w.y = cvt_pk_bf16(x[2], x[3]);
            __builtin_nontemporal_store(w, (u32x2*)(j.WT + (size_t)k * j.dst_ld + j.dst_col + j.n0 + 4 * n4)); }
        return;
    }
#pragma unroll
    for (int h = 0; h < 2; ++h) {
#pragma unroll
        for (int i = 0; i < 8; ++i) { LAS float* s = scr + (4 * i + kr) * 65 + 4 * n4; const f32x4 x = v[8 * h + i]; s[0] = x[0]; s[1] = x[1]; s[2] = x[2]; s[3] = x[3]; }
        f32x4 g0 = {1.f, 1.f, 1.f, 1.f}, g1 = g0;
        if (j.gain) { g0 = *(const f32x4*)(j.gain + j.k0 + 32 * h + 8 * c); g1 = *(const f32x4*)(j.gain + j.k0 + 32 * h + 8 * c + 4); }
        LDS_WAIT(); asm volatile("" ::: "memory");
#pragma unroll
        for (int it = 0; it < 4; ++it) { const int n = 16 * it + (lane >> 2); const LAS float* s = scr + (8 * c) * 65 + n;
            u32x4 o; o.x = cvt_pk_bf16(s[0 * 65] * g0[0], s[1 * 65] * g0[1]); o.y = cvt_pk_bf16(s[2 * 65] * g0[2], s[3 * 65] * g0[3]);
            o.z = cvt_pk_bf16(s[4 * 65] * g1[0], s[5 * 65] * g1[1]); o.w = cvt_pk_bf16(s[6 * 65] * g1[2], s[7 * 65] * g1[3]);
            __builtin_nontemporal_store(o, (u32x4*)(j.WT + (size_t)(j.dst_row + n) * j.dst_ld + j.dst_col + j.k0 + 32 * h + 8 * c)); }
        LDS_WAIT(); asm volatile("" ::: "memory");
    }
}
__device__ __forceinline__ void p_cvt_slot(Frame& F, int l, int first, int count, int part, int nparts) {
    PHASE_IDS();
    LAS float* scr = (LAS float*)(F.lds + wave * 16384);
    unsigned char* ws = F.ws;
    const int step = nparts * NWAVES;
    CvtJob ja, jb; f32x4 va[16], vb[16];
    int r = part * NWAVES + wave;
    if (r < count) { cvt_decode(F.in, ws, l, first + r, ja); cvt_load(ja, va, lane); }
    while (r < count) {
        const int r2 = r + step;
        if (r2 < count) { cvt_decode(F.in, ws, l, first + r2, jb); cvt_load(jb, vb, lane); }
        cvt_store(ja, va, scr, lane);
        if (r2 >= count) break;
        const int r3 = r2 + step;
        if (r3 < count) { cvt_decode(F.in, ws, l, first + r3, ja); cvt_load(ja, va, lane); }
        cvt_store(jb, vb, scr, lane);
        r = r3;
    }
}
__device__ __forceinline__ void cvt_one(const float* const* in, unsigned char* ws, int l, int r, LAS float* scr, int lane) {
    CvtJob j; f32x4 v[16]; cvt_decode(in, ws, l, r, j); cvt_load(j, v, lane); cvt_store(j, v, scr, lane);
}
__device__ __forceinline__ void p_prologue(Frame& F) {
    PHASE_IDS();
    LAS float* scr = (LAS float*)(F.lds + wave * 16384);
    const int gw = F.vcu * NWAVES + wave, NGW = F.G * NWAVES;
    unsigned char* ws = g_(F.ws);
    for (int c = blockIdx.x * 512 + tid; c < HDIM; c += F.G * 512) {
        const float* hl = g_(F.in[5]); float v[4], mx = -3.0e38f;
#pragma unroll
        for (int l = 0; l < 4; ++l) { v[l] = hl[l * HDIM + c]; mx = fmaxf(mx, v[l]); }
        float s = 0.f;
#pragma unroll
        for (int l = 0; l < 4; ++l) { v[l] = expf(v[l] - mx); s += v[l]; }
        const float inv = 1.0f / s; float* LB = (float*)(ws + WS_LB); float cs = 0.f;
        LB[c] = 0.f;
#pragma unroll
        for (int l = 1; l < 4; ++l) { cs += v[l] * inv; LB[l * HDIM + c] = cs; }
    }
    {
        const float* x = g_(F.in[0]); bf16_t* HB = (bf16_t*)(ws + WS_HB); float* SS = (float*)(ws + WS_SS);
        for (int m = gw; m < MROWS; m += NGW) {
            const f32x4* xr = (const f32x4*)(x + (size_t)m * DM) + lane; u32x2* br = (u32x2*)(HB + (size_t)m * DM) + lane;
#pragma unroll
            for (int j = 0; j < 8; ++j) { const f32x4 v = xr[64 * j]; u32x2 w; w.x = cvt_pk_bf16(v[0], v[1]); w.y = cvt_pk_bf16(v[2], v[3]); br[64 * j] = w;
                const float s = wave_sum((v[0] * v[0] + v[1] * v[1]) + (v[2] * v[2] + v[3] * v[3])); if (lane == 0) SS[(size_t)j * MROWS + m] = s; }
        }
        const float* mem = g_(F.in[1]); bf16_t* MB = (bf16_t*)(ws + WS_MEMB); float* RSM = (float*)(ws + WS_RSM);
        for (int m = gw; m < MEMROWS; m += NGW) {
            const f32x4* xr = (const f32x4*)(mem + (size_t)m * DM) + lane; u32x2* br = (u32x2*)(MB + (size_t)m * DM) + lane; float s = 0.f;
#pragma unroll
            for (int j = 0; j < 8; ++j) { const f32x4 v = xr[64 * j]; u32x2 w; w.x = cvt_pk_bf16(v[0], v[1]); w.y = cvt_pk_bf16(v[2], v[3]); br[64 * j] = w; s += (v[0] * v[0] + v[1] * v[1]) + (v[2] * v[2] + v[3] * v[3]); }
            s = wave_sum(s); if (lane == 0) RSM[m] = __builtin_amdgcn_rsqf(s * (1.0f / DM) + EPS);
        }
    }
    {
        constexpr int REST = IT_LAYER - CV_SLOT, NIT = IT_LAYER + (DEPTH - 1) * REST;
        for (int it = gw; it < NIT; it += NGW) {
            int l = 0, r = it;
            if (it >= IT_LAYER) { const int j = it - IT_LAYER; l = 1 + j / REST; r = CV_SLOT + j % REST; }
            if (l == 0 && r >= CV_L0_LATE_LO && r < CV_L0_LATE_HI) continue;
            cvt_one(F.in, ws, l, r, scr, lane);
        }
    }
}

__device__ __forceinline__ void p_pool(Frame& F) {
    PHASE_IDS();
    const bf16_t* ZP = (const bf16_t*)(F.ws + oq(WS_ZP)); bf16_t* PO = (bf16_t*)(F.ws + oq(WS_POOLED));
    for (int id = F.vcu * 512 + tid; id < (MROWS / 8) * 128; id += F.G * 512) {
        const int cg = id & 127, run = id >> 7, r0 = run * 8, t0 = r0 & (SEQ - 1), w = 2 << (cg >> 5);
        f32x4 s0 = {0.f, 0.f, 0.f, 0.f}, s1 = {0.f, 0.f, 0.f, 0.f};
        for (int j = 1; j < w; ++j) if (t0 - j >= 0) { f32x4 a, b; ld_bf16x8(ZP + (size_t)(r0 - j) * PD + 8 * cg, a, b); s0 += a; s1 += b; }
#pragma unroll
        for (int i = 0; i < 8; ++i) { const int t = t0 + i; f32x4 a, b; ld_bf16x8(ZP + (size_t)(r0 + i) * PD + 8 * cg, a, b); s0 += a; s1 += b;
            const float inv = 1.0f / (float)((t + 1) < w ? (t + 1) : w);
            st_bf16x8(PO + (size_t)(r0 + i) * PD + 8 * cg, s0 * inv - a, s1 * inv - b);
            if (t - w + 1 >= 0) { f32x4 c, d; ld_bf16x8(ZP + (size_t)(r0 + i - w + 1) * PD + 8 * cg, c, d); s0 -= c; s1 -= d; } }
    }
}

typedef float hg_f32x2 __attribute__((ext_vector_type(2)));
template <int CTRL> __device__ __forceinline__ float dpp_t(float v) { return __builtin_bit_cast(float, __builtin_amdgcn_mov_dpp(__builtin_bit_cast(int, v), CTRL, 0xf, 0xf, true)); }
#define dpp_f(v, ctrl) dpp_t<ctrl>(v)
constexpr int HG_IMG_BYTES = 34816, HG_IQP = 0, HG_IKP = 17408, HG_IMG_LDS = 36864;
constexpr int HG_VEC = 384;
constexpr int HG_TOT = 0;
constexpr int HS_IMG = 0, HS_VT = 3 * HG_IMG_LDS, HS_PS = HS_VT + 3 * 2304, HS_ST = HS_PS + 2 * 9216, HS_OI = HS_ST + 3 * 4352, HS_END = HS_OI + 2 * 4096;
static_assert(HS_END <= LDSCTL_OFF, "hgrn scan LDS map");
#define HG_BAR() do { asm volatile("s_waitcnt lgkmcnt(0)" ::: "memory"); __builtin_amdgcn_s_barrier(); asm volatile("" ::: "memory"); } while (0)
__device__ __forceinline__ void hgp_load(const float* G, const bf16_t* Q, const bf16_t* KK, int unit, int wave, int lane, hg_f32x2 (&g)[8], unsigned (&q2)[8], unsigned (&k2)[8]) {
    const int b = unit >> 8, h = (unit >> 5) & 7, c = unit & 31;
    const size_t rb = (size_t)b * SEQ + (size_t)c * 64, colb = (size_t)h * 128 + 2 * lane;
#pragma unroll
    for (int i = 0; i < 8; ++i) { const size_t o = (rb + 8 * wave + i) * HDIM + colb; g[i] = *(const hg_f32x2*)(G + o); q2[i] = *(const unsigned*)(Q + o); k2[i] = *(const unsigned*)(KK + o); }
}
__device__ __forceinline__ void hgp_unit(unsigned char* IMG, float* VEC, LAS unsigned char* L, int unit, int par, int wave, int lane, const hg_f32x2 (&g)[8], const unsigned (&q2)[8], const unsigned (&k2)[8]) {
    hg_f32x2 p[8]; p[0] = g[0];
#pragma unroll
    for (int i = 1; i < 8; ++i) p[i] = p[i - 1] + g[i];
    LAS unsigned char* T = L + HG_TOT + par * 4096;
    *(LAS hg_f32x2*)(T + (wave * 128 + 2 * lane) * 4) = p[7];
    HG_BAR();
    hg_f32x2 offs = {0.f, 0.f}, bmid = {0.f, 0.f}, bl = {0.f, 0.f};
#pragma unroll
    for (int s = 0; s < 8; ++s) { const hg_f32x2 ts = *(const LAS hg_f32x2*)(T + (s * 128 + 2 * lane) * 4); if (s < wave) offs += ts; if (s < 4) bmid += ts; bl += ts; }
    unsigned char* img = IMG + (size_t)unit * HG_IMG_BYTES;
#pragma unroll
    for (int i = 0; i < 8; ++i) { const int t = 8 * wave + i; const hg_f32x2 x = offs + p[i] - bmid;
        const float qa = bf_lo(q2[i]), qb = bf_hi(q2[i]), ka = bf_lo(k2[i]), kb = bf_hi(k2[i]);
        const float ep0 = ex2(fminf(x.x, 126.f)), ep1 = ex2(fminf(x.y, 126.f)), ek0 = ex2(fminf(-x.x, 126.f)), ek1 = ex2(fminf(-x.y, 126.f));
        *(unsigned*)(img + HG_IQP + t * 272 + lane * 4) = cvt_pk_bf16(qa * ep0, qb * ep1);
        *(unsigned*)(img + HG_IKP + t * 272 + lane * 4) = cvt_pk_bf16(ka * ek0, kb * ek1); }
    if (wave == 0) { float* v = VEC + (size_t)unit * HG_VEC + 2 * lane;
        hg_f32x2 d; d.x = ex2(bl.x); d.y = ex2(bl.y); *(hg_f32x2*)v = d;
        hg_f32x2 ci; ci.x = ex2(bmid.x); ci.y = ex2(bmid.y); *(hg_f32x2*)(v + 128) = ci;
        hg_f32x2 cd; cd.x = ex2(bl.x - bmid.x); cd.y = ex2(bl.y - bmid.y); *(hg_f32x2*)(v + 256) = cd; }
}
__device__ __forceinline__ void p_hgrn_pre(Frame& F) {
    PHASE_IDS();
    const bf16_t* Q = (const bf16_t*)(F.ws + oq(WS_Q)); const bf16_t* KK = (const bf16_t*)(F.ws + oq(WS_KK)); const float* G = (const float*)(F.ws + oq(WS_G));
    unsigned char* IMG = F.ws + oq(WS_HIMG); float* VEC = (float*)(F.ws + oq(WS_HVEC));
    hg_f32x2 ga[8], gb[8]; unsigned qa[8], qb[8], ka[8], kb[8];
    int u = blockIdx.x;
    if (u < 1024) hgp_load(G, Q, KK, u, wave, lane, ga, qa, ka);
    while (u < 1024) {
        const int u2 = u + F.G;
        if (u2 < 1024) hgp_load(G, Q, KK, u2, wave, lane, gb, qb, kb);
        hgp_unit(IMG, VEC, F.lds, u, 0, wave, lane, ga, qa, ka);
        if (u2 >= 1024) break;
        const int u3 = u2 + F.G;
        if (u3 < 1024) hgp_load(G, Q, KK, u3, wave, lane, ga, qa, ka);
        hgp_unit(IMG, VEC, F.lds, u2, 1, wave, lane, gb, qb, kb);
        u = u3;
    }
    HG_BAR();
}
struct HgCtx { const bf16_t* V; const unsigned char* IMG; const float* VEC; bf16_t* ORAW; float* SSQ; LAS unsigned char* L; int tid, lane, wave, lr, lq, b, h, vs, ubase; unsigned voff; };
__device__ __forceinline__ void hgs_dma(const HgCtx& X, int c, int buf) {
    const char* src = (const char*)X.IMG + (size_t)(X.ubase + c) * HG_IMG_BYTES + (size_t)X.wave * 1024 + X.voff;
    const unsigned dst = (unsigned)__builtin_amdgcn_readfirstlane((int)(unsigned)(size_t)(X.L + HS_IMG + buf * HG_IMG_LDS + X.wave * 1024));
#pragma unroll
    for (int i = 0; i < 9; ++i) { unsigned keep; const char* g = src + i * 4096; const unsigned d = dst + (unsigned)i * 4096u;
        asm volatile("s_mov_b32 %0, m0\n\ts_mov_b32 m0, %2\n\ts_nop 0\n\tglobal_load_lds_dwordx4 %1, off\n\ts_mov_b32 m0, %0" : "=&s"(keep) : "v"(g), "s"(d) : "memory"); }
}
__device__ __forceinline__ unsigned hgs_vload(const HgCtx& X, int c, int k) {
    const int cc = c < SEQ / 64 ? c : SEQ / 64 - 1, idx = (X.tid & 255) + 256 * k;
    return *(const unsigned*)(X.V + ((size_t)X.b * SEQ + (size_t)cc * 64 + (idx >> 3)) * HDIM + X.h * 128 + X.vs * 16 + 2 * (idx & 7));
}
__device__ __forceinline__ f32x4 hgs_vec(const HgCtx& X, int c, int tile, int which) {
    const int cc = c < SEQ / 64 ? c : SEQ / 64 - 1;
    return *(const f32x4*)(X.VEC + (size_t)(X.ubase + cc) * HG_VEC + which * 128 + 16 * tile + 4 * X.lq);
}
typedef short hg_s16x4 __attribute__((ext_vector_type(4)));
__device__ __forceinline__ bf16x8 hgs_kpt(LAS unsigned char* KP, int j, int ks, int lane) {
    const int g = lane >> 4, q = (lane & 15) >> 2, p = lane & 3;
    LAS unsigned char* a0 = KP + (32 * ks + 8 * g + q) * 272 + (16 * j + 4 * p) * 2;
    const hg_s16x4 lo = __builtin_amdgcn_ds_read_tr16_b64_v4i16((LAS hg_s16x4*)a0), hi = __builtin_amdgcn_ds_read_tr16_b64_v4i16((LAS hg_s16x4*)(a0 + 4 * 272));
    bf16x8 r; r[0] = lo[0]; r[1] = lo[1]; r[2] = lo[2]; r[3] = lo[3]; r[4] = hi[0]; r[5] = hi[1]; r[6] = hi[2]; r[7] = hi[3]; return r;
}
struct HgSet { unsigned v2a, v2b; f32x4 dd0, dd1, ci0, ci1, cd0, cd1; };
template <int K3>
__device__ __forceinline__ void hgs_step(const HgCtx& X, int c, HgSet& R, f32x4& st0, f32x4& st1) {
    LAS unsigned char* L = X.L; const int wave = X.wave, lr = X.lr, lq = X.lq, tid = X.tid, lane = X.lane;
    const int par = c & 1; const bool main_on = c < SEQ / 64;
    LAS unsigned char* IM = L + HS_IMG + K3 * HG_IMG_LDS; LAS unsigned char* VT = L + HS_VT + K3 * 2304;
    if (wave < 4) {
        if (c + 1 < SEQ / 64) asm volatile("s_waitcnt vmcnt(9)" ::: "memory"); else asm volatile("s_waitcnt vmcnt(0)" ::: "memory");
    } else if (main_on) {
#pragma unroll
        for (int k = 0; k < 2; ++k) { const unsigned v2 = k ? R.v2b : R.v2a; const int idx = (tid & 255) + 256 * k, s = idx >> 3, vp = idx & 7;
            *(LAS bf16_t*)(VT + (2 * vp) * 144 + s * 2) = (bf16_t)(v2 & 0xffffu); *(LAS bf16_t*)(VT + (2 * vp + 1) * 144 + s * 2) = (bf16_t)(v2 >> 16); } }
    HG_BAR();
    if (wave < 4) {
        if (c + 2 < SEQ / 64) hgs_dma(X, c + 2, (K3 + 2) % 3);
        if (main_on) {
            LAS unsigned char* PS = L + HS_PS + par * 9216;
#pragma unroll
            for (int k = 0; k < 3; ++k) {
                int tt, sx; bool on = true;
                if (wave == 0) { tt = k < 2 ? 3 : 0; sx = k < 2 ? k : 0; }
                else if (wave == 1) { tt = k < 2 ? 3 : 1; sx = k < 2 ? 2 + k : 0; }
                else if (wave == 2) { tt = k < 2 ? 2 : 1; sx = k < 2 ? k : 1; }
                else { tt = 2; sx = 2; on = (k == 0); }
                if (on) { f32x4 a = {0.f, 0.f, 0.f, 0.f};
#pragma unroll
                    for (int ks = 0; ks < 4; ++ks) { const bf16x8 A = *(const LAS bf16x8*)(IM + HG_IKP + (16 * sx + lr) * 272 + (32 * ks + 8 * lq) * 2), B = *(const LAS bf16x8*)(IM + HG_IQP + (16 * tt + lr) * 272 + (32 * ks + 8 * lq) * 2);
                        a = __builtin_amdgcn_mfma_f32_16x16x32_bf16(A, B, a, 0, 0, 0); }
                    if (sx == tt) {
#pragma unroll
                        for (int r = 0; r < 4; ++r) if (4 * lq + r > lr) a[r] = 0.f; }
                    u32x2 w; w.x = cvt_pk_bf16(a[0], a[1]); w.y = cvt_pk_bf16(a[2], a[3]);
                    *(LAS u32x2*)(PS + (16 * tt + lr) * 144 + (16 * sx + 4 * lq) * 2) = w; } }
        }
    } else {
        const int wq = wave - 4;
        HgSet N = R; N.v2a = hgs_vload(X, c + 3, 0); N.v2b = hgs_vload(X, c + 3, 1);
        if (main_on) {
            { f32x4 a2 = {0.f, 0.f, 0.f, 0.f}; LAS unsigned char* ST = L + HS_ST + K3 * 4352;
#pragma unroll
              for (int ks = 0; ks < 4; ++ks) { const bf16x8 A = *(const LAS bf16x8*)(IM + HG_IQP + (16 * wq + lr) * 272 + (32 * ks + 8 * lq) * 2), B = *(const LAS bf16x8*)(ST + lr * 272 + (32 * ks + 8 * lq) * 2);
                  a2 = __builtin_amdgcn_mfma_f32_16x16x32_bf16(A, B, a2, 0, 0, 0); }
              LAS float* OI = (LAS float*)(L + HS_OI + par * 4096);
#pragma unroll
              for (int r = 0; r < 4; ++r) OI[(16 * wq + 4 * lq + r) * 16 + lr] = a2[r]; }
            { LAS unsigned char* STn = L + HS_ST + ((K3 + 1) % 3) * 4352; f32x4 t0 = {0.f, 0.f, 0.f, 0.f}, t1 = t0;
#pragma unroll
              for (int ks = 0; ks < 2; ++ks) { const bf16x8 B = *(const LAS bf16x8*)(VT + lr * 144 + (32 * ks + 8 * lq) * 2);
                  const bf16x8 A0 = hgs_kpt(IM + HG_IKP, wq, ks, lane), A1 = hgs_kpt(IM + HG_IKP, wq + 4, ks, lane);
                  t0 = __builtin_amdgcn_mfma_f32_16x16x32_bf16(A0, B, t0, 0, 0, 0); t1 = __builtin_amdgcn_mfma_f32_16x16x32_bf16(A1, B, t1, 0, 0, 0); }
              st0 = st0 * R.dd0 + t0 * R.cd0; st1 = st1 * R.dd1 + t1 * R.cd1;
              const f32x4 s0 = st0 * R.ci0, s1 = st1 * R.ci1;
              u32x2 w; w.x = cvt_pk_bf16(s0[0], s0[1]); w.y = cvt_pk_bf16(s0[2], s0[3]); *(LAS u32x2*)(STn + lr * 272 + (16 * wq + 4 * lq) * 2) = w;
              w.x = cvt_pk_bf16(s1[0], s1[1]); w.y = cvt_pk_bf16(s1[2], s1[3]); *(LAS u32x2*)(STn + lr * 272 + (16 * (wq + 4) + 4 * lq) * 2) = w; }
            N.dd0 = hgs_vec(X, c + 3, wq, 0); N.dd1 = hgs_vec(X, c + 3, wq + 4, 0); N.ci0 = hgs_vec(X, c + 4, wq, 1); N.ci1 = hgs_vec(X, c + 4, wq + 4, 1);
            N.cd0 = hgs_vec(X, c + 3, wq, 2); N.cd1 = hgs_vec(X, c + 3, wq + 4, 2);
        }
        if (c >= 1) {
            LAS unsigned char* PSp = L + HS_PS + (par ^ 1) * 9216; LAS unsigned char* VTp = L + HS_VT + ((K3 + 2) % 3) * 2304; const LAS float* OIp = (const LAS float*)(L + HS_OI + (par ^ 1) * 4096);
            f32x4 a1 = {0.f, 0.f, 0.f, 0.f};
#pragma unroll
            for (int ks = 0; ks < 2; ++ks) { const bf16x8 A = *(const LAS bf16x8*)(PSp + (16 * wq + lr) * 144 + (32 * ks + 8 * lq) * 2), B = *(const LAS bf16x8*)(VTp + lr * 144 + (32 * ks + 8 * lq) * 2);
                a1 = __builtin_amdgcn_mfma_f32_16x16x32_bf16(A, B, a1, 0, 0, 0); }
            const size_t rowb = (size_t)X.b * SEQ + (size_t)(c - 1) * 64;
#pragma unroll
            for (int r = 0; r < 4; ++r) { const size_t row = rowb + 16 * wq + 4 * lq + r; const float o = a1[r] + OIp[(16 * wq + 4 * lq + r) * 16 + lr];
                X.ORAW[row * HDIM + X.h * 128 + X.vs * 16 + lr] = f2bf(o); float ss = o * o;
                ss += dpp_f(ss, 0xB1); ss += dpp_f(ss, 0x4E); ss += dpp_f(ss, 0x141); ss += dpp_f(ss, 0x140);
                if (lr == 0) X.SSQ[row * 64 + X.h * 8 + X.vs] = ss; }
        }
        R = N;
    }
}
__device__ __forceinline__ void hgs_set(const HgCtx& X, int c, int wq, HgSet& R) {
    R.dd0 = hgs_vec(X, c, wq, 0); R.dd1 = hgs_vec(X, c, wq + 4, 0); R.ci0 = hgs_vec(X, c + 1, wq, 1); R.ci1 = hgs_vec(X, c + 1, wq + 4, 1); R.cd0 = hgs_vec(X, c, wq, 2); R.cd1 = hgs_vec(X, c, wq + 4, 2);
}
__device__ __forceinline__ void p_hgrn_scan(Frame& F) {
    PHASE_IDS();
    HgCtx X; X.V = (const bf16_t*)(F.ws + oq(WS_V)); X.IMG = F.ws + oq(WS_HIMG); X.VEC = (const float*)(F.ws + oq(WS_HVEC));
    X.ORAW = (bf16_t*)(F.ws + oq(WS_ORAW)); X.SSQ = (float*)(F.ws + oq(WS_SSQ)); X.L = F.lds; X.tid = tid; X.lane = lane; X.wave = wave; X.lr = lane & 15; X.lq = lane >> 4; X.voff = (unsigned)lane * 16u;
    for (int unit = F.vcu; unit < 256; unit += F.G) {
        X.vs = unit & 7; X.h = (unit >> 3) & 7; X.b = unit >> 6; X.ubase = (X.b * 8 + X.h) * 32;
        for (int i = tid; i < 4352 / 4; i += 512) ((LAS unsigned*)(X.L + HS_ST))[i] = 0u;
        for (int i = tid; i < 2 * 9216 / 4; i += 512) ((LAS unsigned*)(X.L + HS_PS))[i] = 0u;
        f32x4 st0 = {0.f, 0.f, 0.f, 0.f}, st1 = st0;
        const int wq = wave & 3;
        HgSet Ra, Rb, Rc;
        if (wave < 4) { hgs_dma(X, 0, 0); hgs_dma(X, 1, 1); }
        else { Ra.v2a = hgs_vload(X, 0, 0); Ra.v2b = hgs_vload(X, 0, 1); Rb.v2a = hgs_vload(X, 1, 0); Rb.v2b = hgs_vload(X, 1, 1); Rc.v2a = hgs_vload(X, 2, 0); Rc.v2b = hgs_vload(X, 2, 1);
               hgs_set(X, 0, wq, Ra); hgs_set(X, 1, wq, Rb); hgs_set(X, 2, wq, Rc); }
        for (int c = 0; c < SEQ / 64 + 1; c += 3) {
            hgs_step<0>(X, c, Ra, st0, st1);
            hgs_step<1>(X, c + 1, Rb, st0, st1);
            hgs_step<2>(X, c + 2, Rc, st0, st1);
        }
        HG_BAR();
    }
}
#undef HG_BAR
__device__ __forceinline__ void p_hgrn_norm(Frame& F, int layer, int part, int nparts) {
    PHASE_IDS();
    const bf16_t* ORAW = (const bf16_t*)(F.ws + oq(WS_ORAW)); const bf16_t* OG = (const bf16_t*)(F.ws + oq(WS_OG)); const float* SSQ = (const float*)(F.ws + oq(WS_SSQ));
    const float* gain = g_(F.in[6]) + layer * HDIM; bf16_t* AB = (bf16_t*)(F.ws + oq(WS_AB));
    const int cg = tid & 127, h = cg >> 4;
    const f32x4 n0 = *(const f32x4*)(gain + 8 * cg), n1 = *(const f32x4*)(gain + 8 * cg + 4);
    for (int row0 = part * 4 + (tid >> 7); row0 < MROWS; row0 += nparts * 16) {
        f32x4 q0[4], q1[4]; u32x4 ow[4], gw[4];
#pragma unroll
        for (int u = 0; u < 4; ++u) { const int row = row0 + u * nparts * 4; if (row < MROWS) { const float* sq = SSQ + (size_t)row * 64 + h * 8;
            q0[u] = *(const f32x4*)sq; q1[u] = *(const f32x4*)(sq + 4); ow[u] = *(const u32x4*)(ORAW + (size_t)row * HDIM + 8 * cg); gw[u] = *(const u32x4*)(OG + (size_t)row * HDIM + 8 * cg); } }
#pragma unroll
        for (int u = 0; u < 4; ++u) { const int row = row0 + u * nparts * 4; if (row < MROWS) {
            const float ss = ((q0[u][0] + q0[u][1]) + (q0[u][2] + q0[u][3])) + ((q1[u][0] + q1[u][1]) + (q1[u][2] + q1[u][3]));
            const float rstd = __builtin_amdgcn_rsqf(ss * (1.0f / 128.0f) + EPS);
            const f32x4 o0 = {bf_lo(ow[u].x), bf_hi(ow[u].x), bf_lo(ow[u].y), bf_hi(ow[u].y)}, o1 = {bf_lo(ow[u].z), bf_hi(ow[u].z), bf_lo(ow[u].w), bf_hi(ow[u].w)};
            const f32x4 g0 = {bf_lo(gw[u].x), bf_hi(gw[u].x), bf_lo(gw[u].y), bf_hi(gw[u].y)}, g1 = {bf_lo(gw[u].z), bf_hi(gw[u].z), bf_lo(gw[u].w), bf_hi(gw[u].w)};
            st_bf16x8(AB + (size_t)row * DM + PD + 8 * cg, o0 * rstd * n0 * g0, o1 * rstd * n1 * g1); } }
    }
}
__device__ __forceinline__ void p_final(Frame& F) {
    PHASE_IDS();
    const bf16_t* HB = (const bf16_t*)(F.ws + oq(WS_HB)); const float* SS = (const float*)(F.ws + oq(WS_SS)); const float* nf = g_(F.in[19]);
    const int gw = F.vcu * NWAVES + wave, NGW = F.G * NWAVES;
    for (int m = gw; m < MROWS; m += NGW) {
        float s = 0.f;
#pragma unroll
        for (int j = 0; j < 8; ++j) s += SS[(size_t)j * MROWS + m];
        const float rstd = __builtin_amdgcn_rsqf(s * (1.0f / DM) + EPS);
        const u32x4* hr = (const u32x4*)(HB + (size_t)m * DM) + lane; f32x4* orow = (f32x4*)(g_(F.out) + (size_t)m * DM) + 2 * lane; const f32x4* g4 = (const f32x4*)nf + 2 * lane;
#pragma unroll
        for (int j = 0; j < 4; ++j) { const u32x4 w = hr[64 * j];
            orow[128 * j] = (f32x4){bf_lo(w.x), bf_hi(w.x), bf_lo(w.y), bf_hi(w.y)} * rstd * g4[128 * j];
            orow[128 * j + 1] = (f32x4){bf_lo(w.z), bf_hi(w.z), bf_lo(w.w), bf_hi(w.w)} * rstd * g4[128 * j + 1]; }
    }
}

constexpr int PH_PRO = 0, PH_KV = 1, PH_MQ = 2, PH_L0 = 3, PH_PER_LAYER = 10, PH_FINAL = PH_L0 + DEPTH * PH_PER_LAYER, N_PHASES = PH_FINAL + 1;
struct Args { const float* in[20]; float* out; unsigned char* ws; int lo, hi; };
__global__ void __launch_bounds__(NWAVES * 64, 2) mk_fwd(Args args) {
    extern __shared__ __attribute__((aligned(16))) unsigned char lds_raw[];
    Frame F;
    F.lds = (LAS unsigned char*)lds_raw;
    F.G = gridDim.x; { const int bx = blockIdx.x; F.vcu = (F.G % 8 == 0) ? (bx % 8) * (F.G / 8) + bx / 8 : bx; }
    F.in = args.in; F.out = args.out; F.ws = args.ws;
    unsigned char* ws = g_(args.ws);
    for (int u = threadIdx.x; u < (LDS_BYTES - LDSCTL_OFF) / 4; u += NWAVES * 64) ((LAS unsigned*)(F.lds + LDSCTL_OFF))[u] = 0u;
    __syncthreads();
    const int lo = args.lo, hi = args.hi;
    unsigned* barw = (unsigned*)(ws + WS_CTL) + CW_BAR;
    XcdBarrier bar; bar.bar = barw; bar.x = 0; bar.st = (volatile LAS unsigned*)(F.lds + MISC_OFF) + 8;
    if (hi - lo > 1) bar = xcd_barrier_post(barw, (volatile LAS unsigned*)(F.lds + MISC_OFF) + 8);
#ifndef PHMASK
#define PHMASK 0xFFFFF
#endif
#define EN(j) (((PHMASK) >> (j)) & 1)
#define IN(k) (lo <= (k) && (k) < hi)
#define SEAM(k) do { if (IN(k) && IN((k) + 1)) xcd_barrier(bar); } while (0)
    const int G = F.G, c0 = (int)blockIdx.x;
    LAS unsigned char* ring = F.lds;

    if (EN(0) && IN(PH_PRO)) { p_prologue(F); } SEAM(PH_PRO);

    if (EN(1) && IN(PH_KV)) {
        pg8::Gemm g{(const bf16_t*)(ws + WS_MEMB), (const bf16_t*)(ws + WS_WK), DM, DM, DM}; pg8::Sched S; S.init_plain(MEMROWS / 256, 2 * DEPTH * DM / 256, G, c0, DM, DM);
        pg8::EpiRowScale E{(bf16_t*)(ws + WS_KVB), 2 * DEPTH * DM, nullptr, (const float*)(ws + WS_RSM), 1.0f};
        pg8::gemm_phase<pg8::EpiRowScale>(ring, g, S, E);
    } SEAM(PH_KV);

#define FOLD_MQ(ll, cc, GG) do { unsigned char* w_ = ws + oq(0); pg8::Gemm g{(const bf16_t*)(w_ + WS_KVB) + (size_t)(ll) * DM, (const bf16_t*)(w_ + WS_WL + (size_t)(ll) * WL_SIZE + WL_WXQ), 2 * DEPTH * DM, DM, XHD}; \
        pg8::Sched S; S.init(NB * XH, DM / 256, (GG), (cc), 0, 0, 0, 0, 0, 0); S.mode = 1; \
        pg8::EpiColScale E{(bf16_t*)(w_ + WS_MQ) + (size_t)(ll) * NB * XH * MEML * DM, DM, nullptr}; pg8::gemm_phase<pg8::EpiColScale>(ring, g, S, E); } while (0)
#define FOLD_VW(ll, cc, GG) do { unsigned char* w_ = ws + oq(0); pg8::Gemm g{(const bf16_t*)(w_ + WS_WL + (size_t)(ll) * WL_SIZE + WL_WXO), (const bf16_t*)(w_ + WS_KVB) + (size_t)DEPTH * DM + (size_t)(ll) * DM, DM, 2 * DEPTH * DM, XHD}; \
        pg8::Sched S; S.init(NB * DM / 256, XH, (GG), (cc), 0, 0, 0, 0, 0, 0); S.mode = 2; \
        pg8::EpiColScale E{(bf16_t*)(w_ + WS_VW) + (size_t)(ll) * NB * DM * XH * MEML, XH * MEML, nullptr}; pg8::gemm_phase<pg8::EpiColScale>(ring, g, S, E); } while (0)

    if (EN(2) && IN(PH_MQ)) {
        if (c0 < G / 2) FOLD_MQ(0, c0, G / 2); else FOLD_VW(0, c0 - G / 2, G - G / 2);
    } SEAM(PH_MQ);

    for (int l = 0; l < DEPTH; ++l) {
        const int pb = PH_L0 + l * PH_PER_LAYER;
        unsigned char* wl = ws + oq(WS_WL) + (size_t)l * WL_SIZE;
        if (EN(3) && IN(pb + 0)) {
            pg8::Gemm g{(const bf16_t*)(ws + oq(WS_HB)), (const bf16_t*)(wl + WL_WIN), DM, DM, DM}; pg8::Sched S; S.init_plain(MROWS / 256, INC / 256, G, c0, DM, DM);
            pg8::EpiZ E{(bf16_t*)(ws + oq(WS_ZP)), (bf16_t*)(ws + oq(WS_Q)), (bf16_t*)(ws + oq(WS_KK)), (bf16_t*)(ws + oq(WS_V)), (bf16_t*)(ws + oq(WS_OG)), (bf16_t*)(ws + oq(WS_GA)), (bf16_t*)(ws + oq(WS_GB)),
                        (float*)(ws + oq(WS_G)), (const float*)(ws + oq(WS_SS)), (const float*)(ws + oq(WS_LB)) + l * HDIM};
            S.i1 = 4;
            pg8::gemm_phase<pg8::EpiZ>(ring, g, S, E);
        } SEAM(pb + 0);
        if (EN(4) && IN(pb + 1)) { p_pool(F); p_hgrn_pre(F); } SEAM(pb + 1);
        if (EN(5) && IN(pb + 2)) { p_hgrn_scan(F); } SEAM(pb + 2);
        if (EN(6) && IN(pb + 3)) {
            if (c0 < G / 2) {
                pg8::Gemm g{(const bf16_t*)(ws + oq(WS_POOLED)), (const bf16_t*)(wl + WL_WG), PD, 256, 256}; pg8::Sched S;
                S.init(MROWS / 256, 4, G / 2, c0, (long)256 * PD * 2, 256 * 2, 0, 0, 0, (long)256 * 256 * 2);
                pg8::EpiColScale E{(bf16_t*)(ws + oq(WS_AB)), DM, g_(F.in[4]) + l * PD};
                pg8::gemm_phase<pg8::EpiColScale>(ring, g, S, E);
                {
                    pg8::Gemm g2{(const bf16_t*)(ws + oq(WS_HB)), (const bf16_t*)(wl + WL_WIN), DM, DM, DM}; pg8::Sched S2; S2.init_plain(MROWS / 256, INC / 256, G, c0, DM, DM); S2.i0 = 4;
                    pg8::EpiZ E2{(bf16_t*)(ws + oq(WS_ZP)), (bf16_t*)(ws + oq(WS_Q)), (bf16_t*)(ws + oq(WS_KK)), (bf16_t*)(ws + oq(WS_V)), (bf16_t*)(ws + oq(WS_OG)), (bf16_t*)(ws + oq(WS_GA)), (bf16_t*)(ws + oq(WS_GB)),
                                 (float*)(ws + oq(WS_G)), (const float*)(ws + oq(WS_SS)), (const float*)(ws + oq(WS_LB)) + l * HDIM};
                    pg8::gemm_phase<pg8::EpiZ>(ring, g2, S2, E2); }
            } else {
                p_hgrn_norm(F, l, c0 - G / 2, G - G / 2);
                if (l == 0) p_cvt_slot(F, 0, CV_L0_LATE_LO, CV_L0_LATE_HI - CV_L0_LATE_LO, c0 - G / 2, G - G / 2);
                if (l + 1 < DEPTH) p_cvt_slot(F, l + 1, 0, CV_N1, c0 - G / 2, G - G / 2); }
        } SEAM(pb + 3);
        if (EN(7) && IN(pb + 4)) {
            pg8::Gemm g{(const bf16_t*)(ws + oq(WS_AB)), (const bf16_t*)(wl + WL_WBR), DM, DM, DM}; pg8::Sched S; S.init_plain(MROWS / 256, DM / 256, G, c0, DM, DM);
            pg8::EpiBranch E{(bf16_t*)(ws + oq(WS_MERGED)), (const bf16_t*)(ws + oq(WS_GA)), (const bf16_t*)(ws + oq(WS_GB))};
            pg8::gemm_phase<pg8::EpiBranch>(ring, g, S, E);
        } SEAM(pb + 4);
        if (EN(8) && IN(pb + 5)) {
            pg8::Gemm g{(const bf16_t*)(ws + oq(WS_MERGED)), (const bf16_t*)(wl + WL_WMIX), DM, DM, DM}; pg8::Sched S; S.init_plain(MROWS / 256, DM / 256, G, c0, DM, DM);
            pg8::EpiRes E{(bf16_t*)(ws + oq(WS_HB)), (float*)(ws + oq(WS_SS))};
            pg8::gemm_phase<pg8::EpiRes, false>(ring, g, S, E);
        } SEAM(pb + 5);
        if (EN(9) && IN(pb + 6)) {
            pg8::Gemm g{(const bf16_t*)(ws + oq(WS_HB)), (const bf16_t*)(ws + oq(WS_MQ)) + (size_t)l * NB * XH * MEML * DM, DM, DM, DM}; pg8::Sched S;
            S.init(MROWS / 256, XH, G, c0, (long)256 * DM * 2, 0, 0, (long)XH * MEML * DM * 2, 3, (long)MEML * DM * 2);
            pg8::EpiSoftmax E{(bf16_t*)(ws + oq(WS_P)), XH * MEML, (const float*)(ws + oq(WS_SS)), 0.044194173824159216f};
            pg8::gemm_phase<pg8::EpiSoftmax, false>(ring, g, S, E);
            if (l + 1 < DEPTH && c0 >= G / 2) {
                FOLD_MQ(l + 1, c0 - G / 2, G - G / 2); FOLD_VW(l + 1, c0 - G / 2, G - G / 2);
                p_cvt_slot(F, l + 1, CV_N1, CV_N3, c0 - G / 2, G - G / 2); }
        } SEAM(pb + 6);
        if (EN(10) && IN(pb + 7)) {
            pg8::Gemm g{(const bf16_t*)(ws + oq(WS_P)), (const bf16_t*)(ws + oq(WS_VW)) + (size_t)l * NB * DM * XH * MEML, XH * MEML, XH * MEML, XH * MEML}; pg8::Sched S;
            S.init(MROWS / 256, DM / 256, G, c0, (long)256 * XH * MEML * 2, 0, 0, (long)DM * XH * MEML * 2, 3, (long)256 * XH * MEML * 2);
            pg8::EpiRes E{(bf16_t*)(ws + oq(WS_HB)), (float*)(ws + oq(WS_SS))};
            pg8::gemm_phase<pg8::EpiRes, false>(ring, g, S, E);
        } SEAM(pb + 7);
        if (EN(11) && IN(pb + 8)) {
            pg8::Gemm g{(const bf16_t*)(ws + oq(WS_HB)), (const bf16_t*)(wl + WL_WFI), DM, DM, DM}; pg8::Sched S; S.init_plain(MROWS / 256, 2 * DFF / 256, G, c0, DM, DM);
            pg8::EpiFfn E{(bf16_t*)(ws + oq(WS_ACT)), (const float*)(ws + oq(WS_SS))};
            pg8::gemm_phase<pg8::EpiFfn>(ring, g, S, E);
            if (l + 1 < DEPTH && c0 >= G / 2) p_cvt_slot(F, l + 1, CV_N1 + CV_N3, CV_N2, c0 - G / 2, G - G / 2);
        } SEAM(pb + 8);
        if (EN(12) && IN(pb + 9)) {
            pg8::Gemm g{(const bf16_t*)(ws + oq(WS_ACT)), (const bf16_t*)(wl + WL_WFO), DFF, DFF, DFF}; pg8::Sched S; S.init_plain(MROWS / 256, DM / 256, G, c0, DFF, DFF);
            pg8::EpiRes E{(bf16_t*)(ws + oq(WS_HB)), (float*)(ws + oq(WS_SS))};
            pg8::gemm_phase<pg8::EpiRes, false>(ring, g, S, E);
        } SEAM(pb + 9);
    }
    if (EN(13) && IN(PH_FINAL)) { p_final(F); }
#ifdef PROBE_X
    if (IN(N_PHASES + 0)) { p_pool(F); }
    if (IN(N_PHASES + 1)) { p_hgrn_scan(F); }
    if (IN(N_PHASES + 3)) { p_hgrn_pre(F); }
    if (IN(N_PHASES + 4)) { if (c0 >= G / 2) p_cvt_slot(F, 1, 0, 8192, c0 - G / 2, G - G / 2); }
    if (IN(N_PHASES + 5)) { p_cvt_slot(F, 1, 0, 16384, c0, G); }
    if (IN(N_PHASES + 2)) {
        pg8::Gemm g{(const bf16_t*)(ws + oq(WS_HB)), (const bf16_t*)(ws + oq(WS_WL) + WL_WIN), DM, DM, DM}; pg8::Sched S; S.init_plain(MROWS / 256, INC / 256, G, c0, DM, DM);
        pg8::EpiColScale E{(bf16_t*)(ws + oq(WS_ZP)), INC, nullptr}; pg8::gemm_phase<pg8::EpiColScale>(ring, g, S, E); }
#endif
#undef FOLD_MQ
#undef FOLD_VW
#undef IN
#undef SEAM
}

extern "C" void kernel_launch(void* const* d_in, const int* in_sizes, int n_in, void* d_out, int out_size, void* d_ws, size_t ws_size, hipStream_t stream) {
    static int grid = 0;
    if (grid == 0) {
        if (n_in != 20 || out_size != MROWS * DM || ws_size < WS_END) { fprintf(stderr, "kernel_launch: unexpected problem (n_in %d, out %d, ws %zu < %zu)\n", n_in, out_size, ws_size, (size_t)WS_END); grid = -1; return; }
        if (hipFuncSetAttribute((const void*)mk_fwd, hipFuncAttributeMaxDynamicSharedMemorySize, LDS_BYTES) != hipSuccess) { fprintf(stderr, "kernel_launch: hipFuncSetAttribute failed\n"); grid = -1; return; }
        int per_cu = 0;
        if (hipOccupancyMaxActiveBlocksPerMultiprocessor(&per_cu, (const void*)mk_fwd, NWAVES * 64, LDS_BYTES) != hipSuccess || per_cu < 1) fprintf(stderr, "kernel_launch: occupancy query reports %d\n", per_cu);
        (void)hipGetLastError();
        grid = 256;
    }
    if (grid < 0) return;
    (void)hipMemsetAsync((char*)d_ws + WS_CTL, 0, CTL_ZERO_BYTES, stream);
    Args a{};
    for (int i = 0; i < 20; ++i) a.in[i] = (const float*)d_in[i];
    a.out = (float*)d_out; a.ws = (unsigned char*)d_ws;
#if MK_PER_PHASE
    for (int p = 0; p < N_PHASES; ++p) { a.lo = p; a.hi = p + 1; hipLaunchKernelGGL(mk_fwd, dim3(grid), dim3(NWAVES * 64), LDS_BYTES, stream, a); }
#else
    a.lo = 0; a.hi = N_PHASES; hipLaunchKernelGGL(mk_fwd, dim3(grid), dim3(NWAVES * 64), LDS_BYTES, stream, a);
#endif
#ifdef PROBE_X
    for (int l = 0; l < DEPTH; ++l) { const int p = (PROBE_X < 0) ? (-PROBE_X - 1) : (PROBE_X >= 200 ? PH_L0 + 3 * PH_PER_LAYER + PROBE_X - 200 : (PROBE_X >= 100 ? N_PHASES + PROBE_X - 100 : PH_L0 + l * PH_PER_LAYER + PROBE_X)); a.lo = p; a.hi = p + 1;
        hipLaunchKernelGGL(mk_fwd, dim3(grid), dim3(NWAVES * 64), LDS_BYTES, stream, a); }
#endif
}
```

```cpp
#include <hip/hip_runtime.h>
#include <cstdio>
#include <cstdint>

#ifndef MK_PER_PHASE
#define MK_PER_PHASE 0
#endif

#define LAS __attribute__((address_space(3)))
#define GAS __attribute__((address_space(1)))
typedef unsigned short bf16_t;
typedef short bf16x8 __attribute__((ext_vector_type(8)));
typedef float f32x4 __attribute__((ext_vector_type(4)));
typedef unsigned u32x4 __attribute__((ext_vector_type(4)));
typedef unsigned u32x2 __attribute__((ext_vector_type(2)));

constexpr int DM = 2048, NB = 4, SEQ = 2048, DEPTH = 4, MEML = 256;
constexpr int MROWS = NB * SEQ;
constexpr int MEMROWS = NB * MEML;
constexpr int PD = 1024, HDIM = 1024, XH = 4, XHD = 512, DFF = 5632, INC = 9216;
constexpr float EPS = 1e-6f;
constexpr float LOG2E = 1.4426950408889634f;

typedef __bf16 bf16x2_t __attribute__((ext_vector_type(2)));
typedef float f32x2_t __attribute__((ext_vector_type(2)));
__device__ __forceinline__ unsigned cvt_pk_bf16(float lo, float hi) { const f32x2_t v = {lo, hi}; const bf16x2_t r = __builtin_convertvector(v, bf16x2_t); return __builtin_bit_cast(unsigned, r); }
__device__ __forceinline__ float bf_lo(unsigned w) { return __uint_as_float(w << 16); }
__device__ __forceinline__ float bf_hi(unsigned w) { return __uint_as_float(w & 0xffff0000u); }
__device__ __forceinline__ float bf2f(bf16_t h) { return __uint_as_float(((unsigned)h) << 16); }
__device__ __forceinline__ bf16_t f2bf(float f) { return (bf16_t)(cvt_pk_bf16(f, 0.f) & 0xffffu); }
__device__ __forceinline__ float ex2(float x) { return __builtin_amdgcn_exp2f(x); }
__device__ __forceinline__ float rcpf_(float x) { return __builtin_amdgcn_rcpf(x); }
__device__ __forceinline__ float sigm(float z) { return rcpf_(1.0f + ex2(-z * LOG2E)); }
__device__ __forceinline__ void st_bf16x8(bf16_t* p, const f32x4 a, const f32x4 b) {
    u32x4 w; w.x = cvt_pk_bf16(a[0], a[1]); w.y = cvt_pk_bf16(a[2], a[3]); w.z = cvt_pk_bf16(b[0], b[1]); w.w = cvt_pk_bf16(b[2], b[3]);
    *(u32x4*)p = w;
}
__device__ __forceinline__ void ld_bf16x8(const bf16_t* p, f32x4& a, f32x4& b) {
    const u32x4 w = *(const u32x4*)p;
    a = (f32x4){bf_lo(w.x), bf_hi(w.x), bf_lo(w.y), bf_hi(w.y)}; b = (f32x4){bf_lo(w.z), bf_hi(w.z), bf_lo(w.w), bf_hi(w.w)};
}

namespace pg8 {
constexpr int BM = 256, BK = 64, HALF = 128, HTB = HALF * BK * 2, STAGE_BYTES = 8 * HTB, NXCD = 8, WGM = 8;
__host__ __device__ __forceinline__ int lds_byte(int r, int c) { const int st = (r >> 4) * 2 + (c >> 5), rr = r & 15, cc = c & 31, ob = rr * 64 + cc * 2; return st * 1024 + (ob ^ (((ob >> 9) & 1) << 5)); }
__host__ __device__ __forceinline__ void stage_rc(int b, int& R, int& C) { const int st = b / 1024, sb = b % 1024, swz = sb ^ (((sb >> 9) & 1) << 5); R = (st >> 1) * 16 + swz / 64; C = (st & 1) * 32 + (swz % 64) / 2; }
__host__ __device__ __forceinline__ int perm32(int rho) { const int n = rho >> 4, i = rho & 15; return 8 * (i >> 2) + 4 * n + (i & 3); }

constexpr int RSTD_OFF = 131072, RSTD_UNITS = 6;
struct Unit { int pm, pn; long aoff, boff; };
struct Gemm { const bf16_t* A; const bf16_t* Bt; int lda, ldb, K; };

struct Sched {
    int nM, nN, nwg, G, c, a_sh, b_sh, mode, i0, i1; long a_pm, a_pn, b_pm, b_pn;
    __device__ __forceinline__ void init(int nM_, int nN_, int G_, int c_, long apm, long apn, int ash, long bpm, int bsh, long bpn) {
        nM = nM_; nN = nN_; nwg = nM * nN; G = G_; c = c_; mode = 0; i0 = 0; i1 = 1 << 20; a_pm = apm; a_pn = apn; a_sh = ash; b_pm = bpm; b_sh = bsh; b_pn = bpn; }
    __device__ __forceinline__ void init_plain(int nM_, int nN_, int G_, int c_, int lda, int ldb) { init(nM_, nN_, G_, c_, (long)BM * lda * 2, 0, 0, 0, 0, (long)BM * ldb * 2); }
    __device__ __forceinline__ bool next(int i, Unit& u) const {
        if (i + i0 >= i1) return false;
        const long L = (long)(i + i0) * G + c; if (L >= nwg) return false;
        int wgid = (int)L; { const int q = nwg / NXCD, r = nwg % NXCD, xcd = wgid % NXCD, off = wgid / NXCD; wgid = (xcd < r ? xcd * (q + 1) : r * (q + 1) + (xcd - r) * q) + off; }
        const int nig = WGM * nN, gid = wgid / nig, fm = gid * WGM, gsz = (nM - fm) < WGM ? (nM - fm) : WGM;
        u.pm = fm + ((wgid % nig) % gsz); u.pn = (wgid % nig) / gsz;
        u.aoff = (long)u.pm * a_pm + (long)(u.pn >> a_sh) * a_pn; u.boff = (long)(u.pm >> b_sh) * b_pm + (long)u.pn * b_pn;
        if (mode == 1) {
            u.aoff = (long)(u.pm >> 2) * (256L * 16384 * 2) + (long)(u.pm & 3) * 1024; u.boff = (long)(u.pm & 3) * 1024 + (long)u.pn * (256L * 2048 * 2); }
        else if (mode == 2) {
            u.aoff = (long)(u.pm & 7) * (256L * 2048 * 2) + (long)u.pn * 1024; u.boff = (long)(u.pm >> 3) * (256L * 16384 * 2) + (long)u.pn * 1024; }
        return true;
    }
};

template <class Epi, bool ALIGN_EPI = true>
__device__ __forceinline__ void gemm_phase(LAS unsigned char* lds, const Gemm g, const Sched& S, const Epi& E) {
    int tid = threadIdx.x; asm volatile("" : "+v"(tid));
    const int wid = __builtin_amdgcn_readfirstlane(tid >> 6), lane = tid & 63, wr = wid >> 2, wc = wid & 3, fr = lane & 15, fq = lane >> 4;
    int K = g.K; asm volatile("" : "+s"(K));
    const int nt = K / BK;
    unsigned voffA[2], voffB[2];
#pragma unroll
    for (int i = 0; i < 2; ++i) { int R, C; stage_rc(tid * 16 + i * 8192, R, C); const int Rb = (R & ~31) + perm32(R & 31);
        voffA[i] = (unsigned)(R * g.lda + C) * 2u; voffB[i] = (unsigned)(Rb * g.ldb + C) * 2u; }
    const size_t kstep = (size_t)(BK * 2);
    const size_t hstepA = (size_t)HALF * g.lda * 2, hstepB = (size_t)HALF * g.ldb * 2;
    const unsigned ldsw = (unsigned)wid * 1024u;
    const int aoff = lds_byte(wr * 64 + fr, fq * 8), boff = lds_byte(wc * 32 + fr, fq * 8);
#define PG8_SA(b, h) (((b) * 2 + (h)) * HTB)
#define PG8_SB(b, h) ((4 + (b) * 2 + (h)) * HTB)
#define PG8_STAGE(bufoff, gbase, voff) do { _Pragma("unroll") for (int _i = 0; _i < 2; ++_i) \
        __builtin_amdgcn_global_load_lds((const unsigned*)((const char*)(gbase) + (voff)[_i]), (LAS unsigned*)(lds + (bufoff) + ldsw + _i * 8192), 16, 0, 0); } while (0)
#define PG8_LDA(dst, b, h) do { _Pragma("unroll") for (int m = 0; m < 4; ++m) _Pragma("unroll") for (int k = 0; k < 2; ++k) dst[m][k] = *(const LAS bf16x8*)(lds + PG8_SA(b, h) + aoff + m * 2048 + k * 1024); } while (0)
#define PG8_LDB(dst, b, h) do { _Pragma("unroll") for (int n = 0; n < 2; ++n) _Pragma("unroll") for (int k = 0; k < 2; ++k) dst[n][k] = *(const LAS bf16x8*)(lds + PG8_SB(b, h) + boff + n * 2048 + k * 1024); } while (0)
#define PG8_MMA(ai, bj, At, Bt) do { __builtin_amdgcn_s_setprio(1); _Pragma("unroll") for (int m = 0; m < 4; ++m) _Pragma("unroll") for (int n = 0; n < 2; ++n) _Pragma("unroll") for (int k = 0; k < 2; ++k) \
        acc[ai][bj][m][n] = __builtin_amdgcn_mfma_f32_16x16x32_bf16(Bt[n][k], At[m][k], acc[ai][bj][m][n], 0, 0, 0); __builtin_amdgcn_s_setprio(0); } while (0)
#define PG8_WAIT_V(n) asm volatile("s_waitcnt vmcnt(" #n ")" ::: "memory")
#define PG8_WAIT_L(n) asm volatile("s_waitcnt lgkmcnt(" #n ")" ::: "memory")
#define PG8_BAR __builtin_amdgcn_s_barrier()
#define PG8_WAIT_RELAX(flag, n) asm volatile("s_cmp_eq_u32 %0, 0\n\ts_cbranch_scc1 .Lrw%=\n\ts_waitcnt vmcnt(8)\n.Lrw%=:\n\ts_waitcnt vmcnt(%1)" :: "s"(flag), "n"(n) : "scc", "memory")
#define PG8_SCHED __builtin_amdgcn_sched_barrier(0)
    Unit cur, nxt; int ui = 0;
    if (!S.next(0, cur)) return;
    if constexpr (Epi::USES_RSTD) {
        LAS float* T = (LAS float*)(lds + RSTD_OFF);
#pragma unroll
        for (int k = 0; k < RSTD_UNITS * 256 / 512; ++k) { const int idx = tid + 512 * k; Unit uu;
            if (S.next(idx >> 8, uu)) { const float* sp = E.SS + uu.pm * BM + (idx & 255); float ssum = 0.f;
#pragma unroll
                for (int j = 0; j < 8; ++j) ssum += sp[(size_t)j * MROWS];
                T[idx] = __builtin_amdgcn_rsqf(ssum * (1.0f / DM) + EPS); } }
        asm volatile("s_waitcnt lgkmcnt(0)" ::: "memory"); __builtin_amdgcn_s_barrier(); asm volatile("" ::: "memory");
    }
    f32x4 acc[2][2][4][2];
#pragma unroll
    for (int a = 0; a < 2; ++a)
#pragma unroll
        for (int b = 0; b < 2; ++b)
#pragma unroll
            for (int m = 0; m < 4; ++m)
#pragma unroll
                for (int n = 0; n < 2; ++n) acc[a][b][m][n] = (f32x4){0.f, 0.f, 0.f, 0.f};
    bf16x8 At[4][2], B0[2][2], B1[2][2];
    const char* cA = (const char*)g.A + cur.aoff; const char* cB = (const char*)g.Bt + cur.boff;
    PG8_STAGE(PG8_SB(0, 0), cB, voffB); PG8_STAGE(PG8_SB(0, 1), cB + hstepB, voffB); PG8_STAGE(PG8_SA(0, 0), cA, voffA); PG8_STAGE(PG8_SA(0, 1), cA + hstepA, voffA);
    if (wr == 1) PG8_BAR;
    PG8_WAIT_V(2); PG8_BAR;
    PG8_STAGE(PG8_SB(1, 0), cB + kstep, voffB); PG8_STAGE(PG8_SA(1, 0), cA + kstep, voffA); PG8_STAGE(PG8_SB(1, 1), cB + hstepB + kstep, voffB);
    PG8_WAIT_V(6); PG8_BAR;
    for (;;) {
        const bool has_next = S.next(ui + 1, nxt);
        const char* nA = has_next ? (const char*)g.A + nxt.aoff : cA; const char* nB = has_next ? (const char*)g.Bt + nxt.boff : cB;
        for (int hh = 0; hh < (Epi::HAS_MID ? 2 : 1); ++hh) {
        if constexpr (Epi::HAS_MID) { if (hh == 1) { int le = lane; asm volatile("" : "+v"(le)); E.mid(acc, cur, wr, wc, le & 15, le >> 4); } }
        const int t_lo = Epi::HAS_MID ? hh * (nt >> 1) : 0, t_hi = Epi::HAS_MID ? (hh + 1) * (nt >> 1) : nt;
        for (int t = t_lo; t < t_hi; t += 2) {
            const bool last = (t == nt - 2);
            const char* a1 = cA + (size_t)(t + 1) * kstep;
            const char* a2 = last ? nA : cA + (size_t)(t + 2) * kstep; const char* b2 = last ? nB : cB + (size_t)(t + 2) * kstep;
            const char* a3 = a2 + kstep; const char* b3 = b2 + kstep;
            const int rflag = __builtin_amdgcn_readfirstlane(t | (int)(ui == 0));
            PG8_LDB(B0, 0, 0); PG8_LDB(B1, 0, 1); PG8_SCHED; PG8_LDA(At, 0, 0); PG8_STAGE(PG8_SA(1, 1), a1 + hstepA, voffA);
            if constexpr (Epi::NSTORES > 0) PG8_WAIT_RELAX(rflag, 8 + Epi::NSTORES); else PG8_WAIT_V(8);
            PG8_WAIT_L(0); PG8_BAR; PG8_MMA(0, 0, At, B0); PG8_MMA(0, 1, At, B1); PG8_BAR; PG8_SCHED;
            PG8_LDA(At, 0, 1); PG8_STAGE(PG8_SB(0, 0), b2, voffB); PG8_STAGE(PG8_SB(0, 1), b2 + hstepB, voffB); PG8_STAGE(PG8_SA(0, 0), a2, voffA);
            if constexpr (Epi::NSTORES > 0) PG8_WAIT_RELAX(rflag, 8 + Epi::NSTORES); else PG8_WAIT_V(8);
            PG8_WAIT_L(0); PG8_BAR; PG8_MMA(1, 0, At, B0); PG8_MMA(1, 1, At, B1); PG8_BAR; PG8_SCHED;
            PG8_LDB(B0, 1, 0); PG8_LDB(B1, 1, 1); PG8_SCHED; PG8_LDA(At, 1, 0); PG8_STAGE(PG8_SA(0, 1), a2 + hstepA, voffA);
            PG8_WAIT_V(8); PG8_WAIT_L(0); PG8_BAR; PG8_MMA(0, 0, At, B0); PG8_MMA(0, 1, At, B1); PG8_BAR; PG8_SCHED;
            PG8_LDA(At, 1, 1); PG8_STAGE(PG8_SB(1, 0), b3, voffB); PG8_STAGE(PG8_SB(1, 1), b3 + hstepB, voffB); PG8_STAGE(PG8_SA(1, 0), a3, voffA);
            PG8_WAIT_V(8); PG8_WAIT_L(0); PG8_BAR; PG8_MMA(1, 0, At, B0); PG8_MMA(1, 1, At, B1); PG8_BAR; PG8_SCHED;
        }
        }
        if constexpr (ALIGN_EPI) { if (wr == 0) PG8_BAR; }
        if constexpr (!Epi::AFTER_DRAIN) { int le = lane; asm volatile("" : "+v"(le));
            E(acc, cur, wr, wc, le & 15, le >> 4, ui, lds); }
        if (!has_next) break;
#pragma unroll
        for (int a = 0; a < 2; ++a)
#pragma unroll
            for (int b = 0; b < 2; ++b)
#pragma unroll
                for (int m = 0; m < 4; ++m)
#pragma unroll
                    for (int n = 0; n < 2; ++n) acc[a][b][m][n] = (f32x4){0.f, 0.f, 0.f, 0.f};
        cur = nxt; cA = nA; cB = nB; ++ui;
        if constexpr (ALIGN_EPI) { if (wr == 1) PG8_BAR; }
    }
    PG8_WAIT_V(0);
    if constexpr (!ALIGN_EPI) { if (wr == 0) PG8_BAR; }
    PG8_BAR;
    if constexpr (Epi::AFTER_DRAIN) { int le = lane; asm volatile("" : "+v"(le)); E.fused(acc, cur, wr, wc, le & 15, le >> 4, lds, wid, le); }
#undef PG8_SA
#undef PG8_SB
#undef PG8_STAGE
#undef PG8_LDA
#undef PG8_LDB
#undef PG8_MMA
#undef PG8_WAIT_V
#undef PG8_WAIT_L
#undef PG8_BAR
#undef PG8_SCHED
}

#define ROWG(base, u, ai, m, wr, ld, esz) ((char*)(base) + (size_t)((u).pm * BM + (ai) * HALF + (wr) * 64 + (m) * 16) * (size_t)(ld) * (esz))
__device__ __forceinline__ void load_rstd(const float* SS, const Unit& u, int wr, int fr, int fq, float (&rs)[2][4]) {
    const unsigned loff = (unsigned)((2 * fq) * MROWS + fr) * 4u;
#pragma unroll
    for (int ai = 0; ai < 2; ++ai)
#pragma unroll
        for (int m = 0; m < 4; ++m) { const char* sb = (const char*)(SS + (u.pm * BM + ai * HALF + wr * 64 + m * 16)); const char* sb2 = sb + (size_t)MROWS * 4;
            float s = *(const float*)(sb + loff) + *(const float*)(sb2 + loff);
            s += __shfl_xor(s, 16); s += __shfl_xor(s, 32);
            rs[ai][m] = __builtin_amdgcn_rsqf(s * (1.0f / DM) + EPS); }
}

__device__ __forceinline__ void read_rstd(LAS unsigned char* lds, int ui, int wr, int fr, float (&rs)[2][4]) {
    const LAS float* T = (const LAS float*)(lds + RSTD_OFF) + ui * 256 + wr * 64 + fr;
#pragma unroll
    for (int ai = 0; ai < 2; ++ai)
#pragma unroll
        for (int m = 0; m < 4; ++m) rs[ai][m] = T[ai * HALF + m * 16];
}
__host__ __device__ __forceinline__ int zperm(int t) { return (t == 16 || t == 17) ? t + 4 : ((t == 20 || t == 21) ? t - 4 : t); }
struct EpiZ {
    static constexpr bool USES_RSTD = true, AFTER_DRAIN = false, HAS_MID = false; static constexpr int NSTORES = 16;
    bf16_t *ZP, *Q, *KK, *V, *OG, *GA, *GB; float* G; const float* SS; const float* LB;
    __device__ __forceinline__ void operator()(const f32x4 (&acc)[2][2][4][2], const Unit& u, int wr, int wc, int fr, int fq, int ui, LAS unsigned char* lds) const {
        const int cl = wc * 32 + 8 * fq; const int pn = zperm(u.pn);
        float rs[2][4]; read_rstd(lds, ui, wr, fr, rs);
        if (pn >= 8 && pn < 12) {
            const int cb = (pn - 8) * 256 + cl;
            const unsigned lo4 = (unsigned)(fr * HDIM + cb) * 4u, lo2 = (unsigned)(fr * HDIM + cb) * 2u;
#pragma unroll
            for (int bj = 0; bj < 2; ++bj) {
                const f32x4 l0 = *(const f32x4*)(LB + cb + bj * HALF), l1 = *(const f32x4*)(LB + cb + bj * HALF + 4);
#pragma unroll
                for (int ai = 0; ai < 2; ++ai)
#pragma unroll
                    for (int m = 0; m < 4; ++m) { const float r = rs[ai][m];
                        f32x4 gg[2], kk[2];
#pragma unroll
                        for (int n = 0; n < 2; ++n) { const f32x4 lb = n ? l1 : l0;
#pragma unroll
                            for (int j = 0; j < 4; ++j) { float z = acc[ai][bj][m][n][j] * r; z = fminf(fmaxf(z, -80.f), 80.f);
                                const float e = ex2(-z * LOG2E), sg = rcpf_(1.0f + e), om = 1.0f - lb[j];
                                gg[n][j] = __builtin_amdgcn_logf(lb[j] + om * sg); kk[n][j] = om * e * sg; } }
                        char* gb = ROWG(G, u, ai, m, wr, HDIM, 4) + bj * HALF * 4; char* kb = ROWG(KK, u, ai, m, wr, HDIM, 2) + bj * HALF * 2;
                        *(f32x4*)(gb + lo4) = gg[0]; *(f32x4*)(gb + lo4 + 16) = gg[1];
                        st_bf16x8((bf16_t*)(kb + lo2), kk[0], kk[1]); } }
        } else {
            bf16_t* dst; int ld, cb, ty;
            if (pn < 4) { dst = ZP; ld = PD; cb = pn * 256; ty = 0; }
            else if (pn < 8) { dst = Q; ld = HDIM; cb = (pn - 4) * 256; ty = 1; }
            else if (pn < 16) { dst = V; ld = HDIM; cb = (pn - 12) * 256; ty = 0; }
            else if (pn < 20) { dst = OG; ld = HDIM; cb = (pn - 16) * 256; ty = 1; }
            else if (pn < 28) { dst = GA; ld = DM; cb = (pn - 20) * 256; ty = 2; }
            else { dst = GB; ld = DM; cb = (pn - 28) * 256; ty = 2; }
            const unsigned loff = (unsigned)(fr * ld + cb + cl) * 2u;
#define EPZ_LOOP(BODY) _Pragma("unroll") for (int ai = 0; ai < 2; ++ai) _Pragma("unroll") for (int m = 0; m < 4; ++m) { const float r = rs[ai][m]; const float rn = -r * LOG2E; (void)rn; char* rb = ROWG(dst, u, ai, m, wr, ld, 2); \
                _Pragma("unroll") for (int bj = 0; bj < 2; ++bj) { f32x4 v[2]; _Pragma("unroll") for (int n = 0; n < 2; ++n) { const f32x4 a = acc[ai][bj][m][n]; BODY } \
                    st_bf16x8((bf16_t*)(rb + loff + bj * HALF * 2), v[0], v[1]); } }
            if (ty == 0) { EPZ_LOOP( v[n] = a * r; ) }
            else if (ty == 1) { EPZ_LOOP( const f32x4 t = a * rn; f32x4 e; e[0] = ex2(t[0]); e[1] = ex2(t[1]); e[2] = ex2(t[2]); e[3] = ex2(t[3]); const f32x4 d = e + 1.0f;
                                          f32x4 sg; sg[0] = rcpf_(d[0]); sg[1] = rcpf_(d[1]); sg[2] = rcpf_(d[2]); sg[3] = rcpf_(d[3]); v[n] = (a * r) * sg; ) }
            else { EPZ_LOOP( const f32x4 t = a * rn; f32x4 e; e[0] = ex2(t[0]); e[1] = ex2(t[1]); e[2] = ex2(t[2]); e[3] = ex2(t[3]); const f32x4 d = e + 1.0f;
                             f32x4 sg; sg[0] = rcpf_(d[0]); sg[1] = rcpf_(d[1]); sg[2] = rcpf_(d[2]); sg[3] = rcpf_(d[3]); v[n] = sg; ) }
#undef EPZ_LOOP
        }
    }
};
struct EpiRowScale {
    static constexpr bool USES_RSTD = false, AFTER_DRAIN = false, HAS_MID = false; static constexpr int NSTORES = 16;
    bf16_t* O; int ldc; const float* SS; const float* RS; float cst;
    __device__ __forceinline__ void operator()(const f32x4 (&acc)[2][2][4][2], const Unit& u, int wr, int wc, int fr, int fq, int ui, LAS unsigned char* lds) const {
        const unsigned loff = (unsigned)(fr * ldc + u.pn * BM + wc * 32 + 8 * fq) * 2u;
        float rs[2][4];
        if (SS) load_rstd(SS, u, wr, fr, fq, rs);
        else {
#pragma unroll
            for (int ai = 0; ai < 2; ++ai)
#pragma unroll
                for (int m = 0; m < 4; ++m) rs[ai][m] = *(const float*)((const char*)(RS + (u.pm * BM + ai * HALF + wr * 64 + m * 16)) + (unsigned)fr * 4u); }
#pragma unroll
        for (int ai = 0; ai < 2; ++ai)
#pragma unroll
            for (int m = 0; m < 4; ++m) { const float r = rs[ai][m] * cst; char* rb = ROWG(O, u, ai, m, wr, ldc, 2);
#pragma unroll
                for (int bj = 0; bj < 2; ++bj) st_bf16x8((bf16_t*)(rb + loff + bj * HALF * 2), acc[ai][bj][m][0] * r, acc[ai][bj][m][1] * r); }
    }
};
struct EpiColScale {
    static constexpr bool USES_RSTD = false, AFTER_DRAIN = false, HAS_MID = false; static constexpr int NSTORES = 16;
    bf16_t* O; int ldc; const float* CS;
    __device__ __forceinline__ void operator()(const f32x4 (&acc)[2][2][4][2], const Unit& u, int wr, int wc, int fr, int fq, int ui, LAS unsigned char* lds) const {
        const int col0 = u.pn * BM + wc * 32 + 8 * fq; const unsigned loff = (unsigned)(fr * ldc + col0) * 2u;
        f32x4 cs[2][2];
#pragma unroll
        for (int bj = 0; bj < 2; ++bj)
#pragma unroll
            for (int n = 0; n < 2; ++n) cs[bj][n] = CS ? *(const f32x4*)(CS + col0 + bj * HALF + 4 * n) : (f32x4){1.f, 1.f, 1.f, 1.f};
#pragma unroll
        for (int ai = 0; ai < 2; ++ai)
#pragma unroll
            for (int m = 0; m < 4; ++m) { char* rb = ROWG(O, u, ai, m, wr, ldc, 2);
#pragma unroll
                for (int bj = 0; bj < 2; ++bj) st_bf16x8((bf16_t*)(rb + loff + bj * HALF * 2), acc[ai][bj][m][0] * cs[bj][0], acc[ai][bj][m][1] * cs[bj][1]); }
    }
};
struct EpiFfn {
    static constexpr bool USES_RSTD = true, AFTER_DRAIN = false, HAS_MID = false; static constexpr int NSTORES = 8;
    bf16_t* ACT; const float* SS;
    __device__ __forceinline__ void operator()(const f32x4 (&acc)[2][2][4][2], const Unit& u, int wr, int wc, int fr, int fq, int ui, LAS unsigned char* lds) const {
        const unsigned loff = (unsigned)(fr * DFF + u.pn * HALF + wc * 32 + 8 * fq) * 2u;
        float rs[2][4]; read_rstd(lds, ui, wr, fr, rs);
#pragma unroll
        for (int ai = 0; ai < 2; ++ai)
#pragma unroll
            for (int m = 0; m < 4; ++m) { const float r = rs[ai][m], rn = -r * LOG2E, rr = r * r; f32x4 v[2]; char* rb = ROWG(ACT, u, ai, m, wr, DFF, 2);
#pragma unroll
                for (int n = 0; n < 2; ++n) { const f32x4 g = acc[ai][0][m][n], up = acc[ai][1][m][n]; const f32x4 t = g * rn;
                    f32x4 e; e[0] = ex2(t[0]); e[1] = ex2(t[1]); e[2] = ex2(t[2]); e[3] = ex2(t[3]); const f32x4 d = e + 1.0f;
                    f32x4 sg; sg[0] = rcpf_(d[0]); sg[1] = rcpf_(d[1]); sg[2] = rcpf_(d[2]); sg[3] = rcpf_(d[3]);
                    v[n] = ((g * up) * rr) * sg; }
                st_bf16x8((bf16_t*)(rb + loff), v[0], v[1]); }
    }
};
struct EpiBranch {
    static constexpr bool USES_RSTD = false, AFTER_DRAIN = false, HAS_MID = true; static constexpr int NSTORES = 0;
    bf16_t* O; const bf16_t* GA; const bf16_t* GB;
    __device__ __forceinline__ void mid(f32x4 (&acc)[2][2][4][2], const Unit& u, int wr, int wc, int fr, int fq) const {
        const unsigned loff = (unsigned)(fr * DM + u.pn * BM + wc * 32 + 8 * fq) * 2u;
#pragma unroll
        for (int ai = 0; ai < 2; ++ai) {
            u32x4 ga[4][2], gb[4][2];
#pragma unroll
            for (int m = 0; m < 4; ++m) { const char* pa = ROWG(GA, u, ai, m, wr, DM, 2); const char* pb = ROWG(GB, u, ai, m, wr, DM, 2);
#pragma unroll
                for (int bj = 0; bj < 2; ++bj) { ga[m][bj] = *(const u32x4*)(pa + loff + bj * HALF * 2); gb[m][bj] = *(const u32x4*)(pb + loff + bj * HALF * 2); } }
#pragma unroll
            for (int m = 0; m < 4; ++m)
#pragma unroll
                for (int bj = 0; bj < 2; ++bj) { const u32x4 a = ga[m][bj], g = gb[m][bj];
                    const f32x4 a0 = {bf_lo(a.x), bf_hi(a.x), bf_lo(a.y), bf_hi(a.y)}, a1 = {bf_lo(a.z), bf_hi(a.z), bf_lo(a.w), bf_hi(a.w)};
                    const f32x4 b0 = {bf_lo(g.x), bf_hi(g.x), bf_lo(g.y), bf_hi(g.y)}, b1 = {bf_lo(g.z), bf_hi(g.z), bf_lo(g.w), bf_hi(g.w)};
#pragma unroll
                    for (int j = 0; j < 4; ++j) { acc[ai][bj][m][0][j] *= a0[j] * rcpf_(b0[j]); acc[ai][bj][m][1][j] *= a1[j] * rcpf_(b1[j]); } }
            asm volatile("" ::: "memory"); }
    }
    __device__ __forceinline__ void operator()(const f32x4 (&acc)[2][2][4][2], const Unit& u, int wr, int wc, int fr, int fq, int ui, LAS unsigned char* lds) const {
        const unsigned loff = (unsigned)(fr * DM + u.pn * BM + wc * 32 + 8 * fq) * 2u;
        u32x4 gb[2][4][2];
#pragma unroll
        for (int ai = 0; ai < 2; ++ai)
#pragma unroll
            for (int m = 0; m < 4; ++m) { const char* pb = ROWG(GB, u, ai, m, wr, DM, 2);
#pragma unroll
                for (int bj = 0; bj < 2; ++bj) gb[ai][m][bj] = *(const u32x4*)(pb + loff + bj * HALF * 2); }
#pragma unroll
        for (int ai = 0; ai < 2; ++ai)
#pragma unroll
            for (int m = 0; m < 4; ++m) { char* ob = ROWG(O, u, ai, m, wr, DM, 2);
#pragma unroll
                for (int bj = 0; bj < 2; ++bj) { const u32x4 g = gb[ai][m][bj];
                    const f32x4 b0 = {bf_lo(g.x), bf_hi(g.x), bf_lo(g.y), bf_hi(g.y)}, b1 = {bf_lo(g.z), bf_hi(g.z), bf_lo(g.w), bf_hi(g.w)};
                    st_bf16x8((bf16_t*)(ob + loff + bj * HALF * 2), acc[ai][bj][m][0] * b0, acc[ai][bj][m][1] * b1); } }
    }
};
struct EpiRes {
    static constexpr bool USES_RSTD = false, AFTER_DRAIN = true, HAS_MID = false; static constexpr int NSTORES = 0;
    bf16_t* HB; float* SS;
    __device__ __forceinline__ void fused(f32x4 (&acc)[2][2][4][2], const Unit& u, int wr, int wc, int fr, int fq, LAS unsigned char* lds, int wid, int lane) const {
        LAS float* P = (LAS float*)lds;
        const unsigned lo2 = (unsigned)(fr * DM + u.pn * BM + wc * 32 + 8 * fq) * 2u;
        u32x4 hv[2][4][2];
#pragma unroll
        for (int ai = 0; ai < 2; ++ai)
#pragma unroll
            for (int m = 0; m < 4; ++m) { const char* hb2 = ROWG(HB, u, ai, m, wr, DM, 2);
#pragma unroll
                for (int bj = 0; bj < 2; ++bj) hv[ai][m][bj] = *(const u32x4*)(hb2 + lo2 + bj * HALF * 2); }
#pragma unroll
        for (int ai = 0; ai < 2; ++ai)
#pragma unroll
            for (int m = 0; m < 4; ++m) { const int rl = ai * HALF + wr * 64 + m * 16 + fr; char* hb2 = ROWG(HB, u, ai, m, wr, DM, 2); float s = 0.f;
#pragma unroll
                for (int bj = 0; bj < 2; ++bj) { const u32x4 w = hv[ai][m][bj];
                    const f32x4 h0 = (f32x4){bf_lo(w.x), bf_hi(w.x), bf_lo(w.y), bf_hi(w.y)} + acc[ai][bj][m][0], h1 = (f32x4){bf_lo(w.z), bf_hi(w.z), bf_lo(w.w), bf_hi(w.w)} + acc[ai][bj][m][1];
                    st_bf16x8((bf16_t*)(hb2 + lo2 + bj * HALF * 2), h0, h1);
                    s += (h0[0] * h0[0] + h0[1] * h0[1]) + (h0[2] * h0[2] + h0[3] * h0[3]) + (h1[0] * h1[0] + h1[1] * h1[1]) + (h1[2] * h1[2] + h1[3] * h1[3]); }
                s += __shfl_xor(s, 16); s += __shfl_xor(s, 32);
                if (fq == 0) P[rl * 4 + wc] = s; }
        asm volatile("s_waitcnt lgkmcnt(0)" ::: "memory"); __builtin_amdgcn_s_barrier(); asm volatile("" ::: "memory");
        const int tid = wid * 64 + lane;
        if (tid < 256) { const f32x4 p = *(const LAS f32x4*)(P + tid * 4); SS[(size_t)u.pn * MROWS + u.pm * BM + tid] = (p[0] + p[1]) + (p[2] + p[3]); }
        asm volatile("s_waitcnt lgkmcnt(0)" ::: "memory"); __builtin_amdgcn_s_barrier(); asm volatile("" ::: "memory");
    }
};
struct EpiSoftmax {
    static constexpr bool USES_RSTD = false, AFTER_DRAIN = true, HAS_MID = false; static constexpr int NSTORES = 0;
    bf16_t* P; int ldc; const float* SS; float cst;
    __device__ __forceinline__ void fused(f32x4 (&acc)[2][2][4][2], const Unit& u, int wr, int wc, int fr, int fq, LAS unsigned char* lds, int wid, int lane) const {
        LAS float* X1 = (LAS float*)lds; LAS float* X2 = (LAS float*)(lds + 4096);
        const unsigned loff = (unsigned)(fr * ldc + u.pn * BM + wc * 32 + 8 * fq) * 2u;
        float rs[2][4]; load_rstd(SS, u, wr, fr, fq, rs);
#pragma unroll
        for (int ai = 0; ai < 2; ++ai)
#pragma unroll
            for (int m = 0; m < 4; ++m) { const int rl = ai * HALF + wr * 64 + m * 16 + fr; const float r = rs[ai][m] * cst; float mx = -3.0e38f;
#pragma unroll
                for (int bj = 0; bj < 2; ++bj)
#pragma unroll
                    for (int n = 0; n < 2; ++n)
#pragma unroll
                        for (int j = 0; j < 4; ++j) { const float v = acc[ai][bj][m][n][j] * r; acc[ai][bj][m][n][j] = v; mx = fmaxf(mx, v); }
                mx = fmaxf(mx, __shfl_xor(mx, 16)); mx = fmaxf(mx, __shfl_xor(mx, 32));
                if (fq == 0) X1[rl * 4 + wc] = mx; }
        asm volatile("s_waitcnt lgkmcnt(0)" ::: "memory"); __builtin_amdgcn_s_barrier(); asm volatile("" ::: "memory");
#pragma unroll
        for (int ai = 0; ai < 2; ++ai)
#pragma unroll
            for (int m = 0; m < 4; ++m) { const int rl = ai * HALF + wr * 64 + m * 16 + fr; const f32x4 q = *(const LAS f32x4*)(X1 + rl * 4);
                const float mx = fmaxf(fmaxf(q[0], q[1]), fmaxf(q[2], q[3])) * LOG2E; float s = 0.f;
#pragma unroll
                for (int bj = 0; bj < 2; ++bj)
#pragma unroll
                    for (int n = 0; n < 2; ++n)
#pragma unroll
                        for (int j = 0; j < 4; ++j) { const float e = ex2(acc[ai][bj][m][n][j] * LOG2E - mx); acc[ai][bj][m][n][j] = e; s += e; }
                s += __shfl_xor(s, 16); s += __shfl_xor(s, 32);
                if (fq == 0) X2[rl * 4 + wc] = s; }
        asm volatile("s_waitcnt lgkmcnt(0)" ::: "memory"); __builtin_amdgcn_s_barrier(); asm volatile("" ::: "memory");
#pragma unroll
        for (int ai = 0; ai < 2; ++ai)
#pragma unroll
            for (int m = 0; m < 4; ++m) { const int rl = ai * HALF + wr * 64 + m * 16 + fr; const f32x4 q = *(const LAS f32x4*)(X2 + rl * 4);
                const float inv = 1.0f / ((q[0] + q[1]) + (q[2] + q[3])); char* rb = ROWG(P, u, ai, m, wr, ldc, 2);
#pragma unroll
                for (int bj = 0; bj < 2; ++bj) st_bf16x8((bf16_t*)(rb + loff + bj * HALF * 2), acc[ai][bj][m][0] * inv, acc[ai][bj][m][1] * inv); }
        asm volatile("s_waitcnt lgkmcnt(0)" ::: "memory"); __builtin_amdgcn_s_barrier(); asm volatile("" ::: "memory");
    }
};
}

constexpr size_t MiB = 1u << 20;
constexpr size_t WS_CTL = 0, CTL_ZERO_BYTES = 1 * MiB;
constexpr size_t WS_LB = 1 * MiB;
constexpr size_t WS_RSM = 1 * MiB + 64 * 1024;
constexpr size_t WS_SS = 1 * MiB + 128 * 1024;
constexpr size_t WS_SSQ = 2 * MiB;
constexpr size_t WS_WL = 4 * MiB;
constexpr size_t WL_WIN = 0, WL_WG = 36 * MiB, WL_WBR = 37 * MiB, WL_WMIX = 45 * MiB, WL_WXQ = 53 * MiB, WL_WXO = 61 * MiB, WL_WFI = 69 * MiB, WL_WFO = 113 * MiB, WL_SIZE = 135 * MiB;
constexpr size_t WS_WK = WS_WL + 4 * WL_SIZE;
constexpr size_t WS_WV = WS_WK + 32 * MiB;
constexpr size_t WS_HB = WS_WV + 32 * MiB;
constexpr size_t WS_ZP = WS_HB + 32 * MiB;
constexpr size_t WS_Q = WS_ZP + 16 * MiB;
constexpr size_t WS_KK = WS_Q + 16 * MiB;
constexpr size_t WS_V = WS_KK + 16 * MiB;
constexpr size_t WS_G = WS_V + 16 * MiB;
constexpr size_t WS_OG = WS_G + 32 * MiB;
constexpr size_t WS_GA = WS_OG + 16 * MiB;
constexpr size_t WS_GB = WS_GA + 32 * MiB;
constexpr size_t WS_POOLED = WS_GB + 32 * MiB;
constexpr size_t WS_AB = WS_POOLED + 16 * MiB;
constexpr size_t WS_ORAW = WS_AB + 32 * MiB;
constexpr size_t WS_MERGED = WS_ORAW + 16 * MiB;
constexpr size_t WS_P = WS_MERGED + 32 * MiB;
constexpr size_t WS_ACT = WS_P + 16 * MiB;
constexpr size_t WS_KVB = WS_ACT + 88 * MiB;
constexpr size_t WS_MQ = WS_KVB + 32 * MiB;
constexpr size_t WS_VW = WS_MQ + 64 * MiB;
constexpr size_t WS_MEMB = WS_VW + 64 * MiB;
constexpr size_t WS_HIMG = WS_MEMB + 4 * MiB;
constexpr size_t WS_HVEC = WS_HIMG + 52 * MiB;
constexpr size_t WS_END = WS_HVEC + 2 * MiB;
constexpr size_t WS_HU = WS_MERGED;
constexpr size_t WS_HST = WS_ACT;
constexpr int CW_BAR = 4096;

constexpr int RING_BYTES = 131072, LDS_BYTES = 163840, LDSCTL_OFF = LDS_BYTES - 1024, MISC_OFF = LDSCTL_OFF + 320;
constexpr int NWAVES = 8;

#define XB_TMO      128
#define XB_XCNT(j)  (256  + 64 * (j))
#define XB_XSUB(j)  (1280 + 64 * (j))
#define XB_XGEN(j)  (2304 + 64 * (j))
#define XB_TOP      3328
#define XB_TOPGEN   3392
#define XCD_BAR_WORDS 3456
#define XB_SPIN_CAP (1u << 18)
__device__ __forceinline__ unsigned xb_ld(unsigned* p)              { return __hip_atomic_load(p, __ATOMIC_RELAXED, __HIP_MEMORY_SCOPE_AGENT); }
__device__ __forceinline__ unsigned xb_add(unsigned* p, unsigned v) { return __hip_atomic_fetch_add(p, v, __ATOMIC_RELAXED, __HIP_MEMORY_SCOPE_AGENT); }
__device__ __forceinline__ unsigned xb_xcc_id() { return (unsigned)__builtin_amdgcn_s_getreg((3 << 11) | 20) & 0xFu; }
#define XB_SPIN(cond, bar) do { unsigned _sp = 0; while (cond) { __builtin_amdgcn_s_sleep(1); \
    if ((++_sp & 255u) == 0u) { if (xb_ld(&(bar)[XB_TMO])) break; if (_sp > XB_SPIN_CAP) { atomicAdd(&(bar)[XB_TMO], 1u); break; } } } } while (0)
struct XcdBarrier { unsigned* bar; unsigned x; volatile LAS unsigned* st; };
__device__ __forceinline__ XcdBarrier xcd_barrier_post(unsigned* bar, volatile LAS unsigned* st) {
    XcdBarrier b; b.bar = bar; b.x = xb_xcc_id(); b.st = st;
    if (threadIdx.x == 0) (void)xb_add(&bar[XB_XCNT(b.x)], 1u);
    return b;
}
__device__ __forceinline__ void xcd_barrier_complete(unsigned* bar, unsigned x, unsigned& nloc, unsigned& nx) {
    const unsigned G = gridDim.x * gridDim.y * gridDim.z;
    unsigned sum, cnt, mine, sp = 0u;
    for (;;) {
        sum = 0u; cnt = 0u; mine = 0u;
#pragma unroll
        for (unsigned j = 0; j < 16; ++j) { const unsigned c = xb_ld(&bar[XB_XCNT(j)]); sum += c; cnt += (c > 0u) ? 1u : 0u; mine = (j == x) ? c : mine; }
        if (sum == G) break;
        __builtin_amdgcn_s_sleep(1);
        if ((++sp & 255u) == 0u) { if (xb_ld(&bar[XB_TMO])) break; if (sp > XB_SPIN_CAP) { atomicAdd(&bar[XB_TMO], 1u); break; } }
    }
    nloc = mine > 0u ? mine : 1u; nx = cnt > 0u ? cnt : 1u;
}
__device__ __forceinline__ void xcd_barrier(const XcdBarrier& b) {
    asm volatile("s_waitcnt vmcnt(0)" ::: "memory");
    __syncthreads();
    if (threadIdx.x == 0) {
        unsigned* bar = b.bar;
        __builtin_amdgcn_s_waitcnt(0);
        unsigned nloc = b.st[0], nx = b.st[1];
        if (nloc == 0u) { xcd_barrier_complete(bar, b.x, nloc, nx); b.st[0] = nloc; b.st[1] = nx; }
        const unsigned old = xb_add(&bar[XB_XSUB(b.x)], 1u);
        const unsigned gen = old / nloc;
        if (old + 1u == (gen + 1u) * nloc) {
            __builtin_amdgcn_fence(__ATOMIC_RELEASE, "agent");
            asm volatile("s_waitcnt vmcnt(0)" ::: "memory");
            const unsigned og = xb_add(&bar[XB_TOP], 1u);
            const unsigned tg = og / nx;
            if (og + 1u == (tg + 1u) * nx) xb_add(&bar[XB_TOPGEN], 1u);
            else XB_SPIN(xb_ld(&bar[XB_TOPGEN]) == tg, bar);
            __builtin_amdgcn_fence(__ATOMIC_ACQUIRE, "agent");
            xb_add(&bar[XB_XGEN(b.x)], 1u);
            asm volatile("s_waitcnt vmcnt(0)" ::: "memory");
        } else {
            XB_SPIN(xb_ld(&bar[XB_XGEN(b.x)]) == gen, bar);
            __builtin_amdgcn_fence(__ATOMIC_ACQUIRE, "agent");
            asm volatile("s_waitcnt vmcnt(0)" ::: "memory");
        }
    }
    __syncthreads();
}

struct Frame {
    LAS unsigned char* lds;
    int vcu, G;
    const float* const* in; float* out; unsigned char* ws;
};
#define LDS_WAIT() asm volatile("s_waitcnt lgkmcnt(0)" ::: "memory")
__device__ __forceinline__ int opaque_tid() { int t = threadIdx.x; asm volatile("" : "+v"(t)); return t; }
template <class T> __device__ __forceinline__ T* g_(T* p) { return (T*)(GAS T*)p; }
__device__ __forceinline__ size_t oq(size_t c) { asm volatile("" : "+s"(c)); return c; }
#define PHASE_IDS() const int tid = opaque_tid(), lane = tid & 63, wave = __builtin_amdgcn_readfirstlane(tid >> 6); (void)lane; (void)wave
__device__ __forceinline__ float wave_sum(float v) {
#pragma unroll
    for (int o = 1; o < 64; o <<= 1) v += __shfl_xor(v, o);
    return v;
}

constexpr int IT_WIN = 32 * 144, IT_WG = 64, IT_BR = 16 * 32, IT_SQ = 32 * 32, IT_FI = 32 * 176, IT_FO = 88 * 32;
constexpr int IT_LAYER = IT_WIN + IT_WG + 2 * IT_BR + 5 * IT_SQ + IT_FI + IT_FO;
constexpr int CV_N1 = 8096, CV_N3 = 1024, CV_N2 = 8096, CV_SLOT = CV_N1 + CV_N3 + CV_N2;
constexpr int CV_L0_LATE_LO = 2 * IT_SQ + IT_WIN + IT_WG + 2 * IT_BR + IT_SQ, CV_L0_LATE_HI = CV_L0_LATE_LO + IT_FI + IT_FO;
static_assert(CV_SLOT <= IT_LAYER - 2 * IT_SQ, "the K/V weight items (last in a layer) always belong to the prologue");
struct CvtJob { const float* W; const float* gain; bf16_t* WT; int src_ld, dst_ld, k0, n0, dst_col, plain; long dst_row; };
__device__ __forceinline__ void cvt_decode(const float* const* in, unsigned char* ws, int l, int r, CvtJob& j) {
    unsigned char* wl = ws + WS_WL + (size_t)l * WL_SIZE;
    j.gain = nullptr; j.dst_col = 0; j.src_ld = DM; j.dst_ld = DM; j.plain = 0;
    if (r < IT_SQ) { const int kb = r / 32, nb = r % 32; j.W = g_(in[13]) + (size_t)l * DM * DM; j.gain = g_(in[12]) + l * DM; j.WT = (bf16_t*)(wl + WL_WXQ); j.k0 = 64 * kb; j.n0 = 64 * nb; j.dst_row = 0; j.plain = 1; return; } r -= IT_SQ;
    if (r < IT_SQ) { const int kb = r / 32, nb = r % 32; j.W = g_(in[15]) + (size_t)l * DM * DM; j.WT = (bf16_t*)(wl + WL_WXO); j.k0 = 64 * kb; j.n0 = 64 * nb; j.dst_row = 64 * nb; return; } r -= IT_SQ;
    if (r < IT_WIN) { const int kb = r / 144, nb = r % 144; j.W = g_(in[2]) + (size_t)l * DM * INC; j.src_ld = INC; j.gain = g_(in[10]) + l * DM; j.WT = (bf16_t*)(wl + WL_WIN); j.k0 = 64 * kb; j.n0 = 64 * nb; j.dst_row = 256 * pg8::zperm(nb >> 2) + 64 * (nb & 3); return; } r -= IT_WIN;
    if (r < IT_WG) { const int g = r / 16, rr = r % 16, kb = rr / 4, nb = rr % 4; j.W = g_(in[3]) + (size_t)(l * 4 + g) * 256 * 256; j.src_ld = 256; j.WT = (bf16_t*)(wl + WL_WG); j.dst_ld = 256; j.k0 = 64 * kb; j.n0 = 64 * nb; j.dst_row = g * 256 + 64 * nb; return; } r -= IT_WG;
    if (r < IT_BR) { const int kb = r / 32, nb = r % 32; j.W = g_(in[7]) + (size_t)l * PD * DM; j.WT = (bf16_t*)(wl + WL_WBR); j.k0 = 64 * kb; j.n0 = 64 * nb; j.dst_row = 64 * nb; return; } r -= IT_BR;
    if (r < IT_BR) { const int kb = r / 32, nb = r % 32; j.W = g_(in[8]) + (size_t)l * HDIM * DM; j.WT = (bf16_t*)(wl + WL_WBR); j.k0 = 64 * kb; j.n0 = 64 * nb; j.dst_row = 64 * nb; j.dst_col = PD; return; } r -= IT_BR;
    if (r < IT_SQ) { const int kb = r / 32, nb = r % 32; j.W = g_(in[9]) + (size_t)l * DM * DM; j.WT = (bf16_t*)(wl + WL_WMIX); j.k0 = 64 * kb; j.n0 = 64 * nb; j.dst_row = 64 * nb; return; } r -= IT_SQ;
    if (r < IT_FI) { const int kb = r / 176, nb = r % 176, n0 = 64 * nb, s = n0 / DFF, jj = n0 % DFF; j.W = g_(in[17]) + (size_t)l * DM * 2 * DFF; j.src_ld = 2 * DFF; j.gain = g_(in[16]) + l * DM; j.WT = (bf16_t*)(wl + WL_WFI);
        j.k0 = 64 * kb; j.n0 = n0; j.dst_row = 256 * (jj / 128) + 128 * s + (jj % 128); return; } r -= IT_FI;
    if (r < IT_FO) { const int kb = r / 32, nb = r % 32; j.W = g_(in[18]) + (size_t)l * DFF * DM; j.WT = (bf16_t*)(wl + WL_WFO); j.dst_ld = DFF; j.k0 = 64 * kb; j.n0 = 64 * nb; j.dst_row = 64 * nb; return; } r -= IT_FO;
    if (r < IT_SQ) { const int kb = r / 32, nb = r % 32; j.W = g_(in[14]) + (size_t)l * DM * 2 * DM; j.src_ld = 2 * DM; j.gain = g_(in[11]) + l * DM; j.WT = (bf16_t*)(ws + WS_WK); j.k0 = 64 * kb; j.n0 = 64 * nb; j.dst_row = (long)l * DM + 64 * nb; return; } r -= IT_SQ;
    { const int kb = r / 32, nb = r % 32; j.W = g_(in[14]) + (size_t)l * DM * 2 * DM + DM; j.src_ld = 2 * DM; j.gain = g_(in[11]) + l * DM; j.WT = (bf16_t*)(ws + WS_WV); j.k0 = 64 * kb; j.n0 = 64 * nb; j.dst_row = (long)l * DM + 64 * nb; }
}
__device__ __forceinline__ void cvt_load(const CvtJob& j, f32x4 (&v)[16], int lane) {
    const int kr = lane >> 4, n4 = lane & 15;
#pragma unroll
    for (int i = 0; i < 16; ++i) v[i] = __builtin_nontemporal_load((const f32x4*)(j.W + (size_t)(j.k0 + 4 * i + kr) * j.src_ld + j.n0 + 4 * n4));
}
__device__ __forceinline__ void cvt_store(const CvtJob& j, const f32x4 (&v)[16], LAS float* scr, int lane) {
    const int kr = lane >> 4, n4 = lane & 15, c = lane & 3;
    if (j.plain) {
#pragma unroll
        for (int i = 0; i < 16; ++i) { const int k = j.k0 + 4 * i + kr; const float g = j.gain ? j.gain[k] : 1.0f; const f32x4 x = v[i] * g;
            u32x2 w; w.x = cvt_pk_bf16(x[0], x[1]); w.y = cvt_pk_bf16(x[2], x[3]);
            __builtin_nontemporal_store(w, (u32x2*)(j.WT + (size_t)k * j.dst_ld + j.dst_col + j.n0 + 4 * n4)); }
        return;
    }
#pragma unroll
    for (int h = 0; h < 2; ++h) {
#pragma unroll
        for (int i = 0; i < 8; ++i) { LAS float* s = scr + (4 * i + kr) * 65 + 4 * n4; const f32x4 x = v[8 * h + i]; s[0] = x[0]; s[1] = x[1]; s[2] = x[2]; s[3] = x[3]; }
        f32x4 g0 = {1.f, 1.f, 1.f, 1.f}, g1 = g0;
        if (j.gain) { g0 = *(const f32x4*)(j.gain + j.k0 + 32 * h + 8 * c); g1 = *(const f32x4*)(j.gain + j.k0 + 32 * h + 8 * c + 4); }
        LDS_WAIT(); asm volatile("" ::: "memory");
#pragma unroll
        for (int it = 0; it < 4; ++it) { const int n = 16 * it + (lane >> 2); const LAS float* s = scr + (8 * c) * 65 + n;
            u32x4 o; o.x = cvt_pk_bf16(s[0 * 65] * g0[0], s[1 * 65] * g0[1]); o.y = cvt_pk_bf16(s[2 * 65] * g0[2], s[3 * 65] * g0[3]);
            o.z = cvt_pk_bf16(s[4 * 65] * g1[0], s[5 * 65] * g1[1]); o.w = cvt_pk_bf16(s[6 * 65] * g1[2], s[7 * 65] * g1[3]);
            __builtin_nontemporal_store(o, (u32x4*)(j.WT + (size_t)(j.dst_row + n) * j.dst_ld + j.dst_col + j.k0 + 32 * h + 8 * c)); }
        LDS_WAIT(); asm volatile("" ::: "memory");
    }
}
__device__ __forceinline__ void p_cvt_slot(Frame& F, int l, int first, int count, int part, int nparts) {
    PHASE_IDS();
    LAS float* scr = (LAS float*)(F.lds + wave * 16384);
    unsigned char* ws = F.ws;
    const int step = nparts * NWAVES;
    CvtJob ja, jb; f32x4 va[16], vb[16];
    int r = part * NWAVES + wave;
    if (r < count) { cvt_decode(F.in, ws, l, first + r, ja); cvt_load(ja, va, lane); }
    while (r < count) {
        const int r2 = r + step;
        if (r2 < count) { cvt_decode(F.in, ws, l, first + r2, jb); cvt_load(jb, vb, lane); }
        cvt_store(ja, va, scr, lane);
        if (r2 >= count) break;
        const int r3 = r2 + step;
        if (r3 < count) { cvt_decode(F.in, ws, l, first + r3, ja); cvt_load(ja, va, lane); }
        cvt_store(jb, vb, scr, lane);
        r = r3;
    }
}
__device__ __forceinline__ void cvt_one(const float* const* in, unsigned char* ws, int l, int r, LAS float* scr, int lane) {
    CvtJob j; f32x4 v[16]; cvt_decode(in, ws, l, r, j); cvt_load(j, v, lane); cvt_store(j, v, scr, lane);
}
__device__ __forceinline__ void p_prologue(Frame& F) {
    PHASE_IDS();
    LAS float* scr = (LAS float*)(F.lds + wave * 16384);
    const int gw = F.vcu * NWAVES + wave, NGW = F.G * NWAVES;
    unsigned char* ws = g_(F.ws);
    for (int c = blockIdx.x * 512 + tid; c < HDIM; c += F.G * 512) {
        const float* hl = g_(F.in[5]); float v[4], mx = -3.0e38f;
#pragma unroll
        for (int l = 0; l < 4; ++l) { v[l] = hl[l * HDIM + c]; mx = fmaxf(mx, v[l]); }
        float s = 0.f;
#pragma unroll
        for (int l = 0; l < 4; ++l) { v[l] = expf(v[l] - mx); s += v[l]; }
        const float inv = 1.0f / s; float* LB = (float*)(ws + WS_LB); float cs = 0.f;
        LB[c] = 0.f;
#pragma unroll
        for (int l = 1; l < 4; ++l) { cs += v[l] * inv; LB[l * HDIM + c] = cs; }
    }
    {
        const float* x = g_(F.in[0]); bf16_t* HB = (bf16_t*)(ws + WS_HB); float* SS = (float*)(ws + WS_SS);
        for (int m = gw; m < MROWS; m += NGW) {
            const f32x4* xr = (const f32x4*)(x + (size_t)m * DM) + lane; u32x2* br = (u32x2*)(HB + (size_t)m * DM) + lane;
#pragma unroll
            for (int j = 0; j < 8; ++j) { const f32x4 v = xr[64 * j]; u32x2 w; w.x = cvt_pk_bf16(v[0], v[1]); w.y = cvt_pk_bf16(v[2], v[3]); br[64 * j] = w;
                const float s = wave_sum((v[0] * v[0] + v[1] * v[1]) + (v[2] * v[2] + v[3] * v[3])); if (lane == 0) SS[(size_t)j * MROWS + m] = s; }
        }
        const float* mem = g_(F.in[1]); bf16_t* MB = (bf16_t*)(ws + WS_MEMB); float* RSM = (float*)(ws + WS_RSM);
        for (int m = gw; m < MEMROWS; m += NGW) {
            const f32x4* xr = (const f32x4*)(mem + (size_t)m * DM) + lane; u32x2* br = (u32x2*)(MB + (size_t)m * DM) + lane; float s = 0.f;
#pragma unroll
            for (int j = 0; j < 8; ++j) { const f32x4 v = xr[64 * j]; u32x2 w; w.x = cvt_pk_bf16(v[0], v[1]); w.y = cvt_pk_bf16(v[2], v[3]); br[64 * j] = w; s += (v[0] * v[0] + v[1] * v[1]) + (v[2] * v[2] + v[3] * v[3]); }
            s = wave_sum(s); if (lane == 0) RSM[m] = __builtin_amdgcn_rsqf(s * (1.0f / DM) + EPS);
        }
    }
    {
        constexpr int REST = IT_LAYER - CV_SLOT, NIT = IT_LAYER + (DEPTH - 1) * REST;
        for (int it = gw; it < NIT; it += NGW) {
            int l = 0, r = it;
            if (it >= IT_LAYER) { const int j = it - IT_LAYER; l = 1 + j / REST; r = CV_SLOT + j % REST; }
            if (l == 0 && r >= CV_L0_LATE_LO && r < CV_L0_LATE_HI) continue;
            cvt_one(F.in, ws, l, r, scr, lane);
        }
    }
}

__device__ __forceinline__ void p_pool(Frame& F) {
    PHASE_IDS();
    const bf16_t* ZP = (const bf16_t*)(F.ws + oq(WS_ZP)); bf16_t* PO = (bf16_t*)(F.ws + oq(WS_POOLED));
    for (int id = F.vcu * 512 + tid; id < (MROWS / 8) * 128; id += F.G * 512) {
        const int cg = id & 127, run = id >> 7, r0 = run * 8, t0 = r0 & (SEQ - 1), w = 2 << (cg >> 5);
        f32x4 s0 = {0.f, 0.f, 0.f, 0.f}, s1 = {0.f, 0.f, 0.f, 0.f};
        for (int j = 1; j < w; ++j) if (t0 - j >= 0) { f32x4 a, b; ld_bf16x8(ZP + (size_t)(r0 - j) * PD + 8 * cg, a, b); s0 += a; s1 += b; }
#pragma unroll
        for (int i = 0; i < 8; ++i) { const int t = t0 + i; f32x4 a, b; ld_bf16x8(ZP + (size_t)(r0 + i) * PD + 8 * cg, a, b); s0 += a; s1 += b;
            const float inv = 1.0f / (float)((t + 1) < w ? (t + 1) : w);
            st_bf16x8(PO + (size_t)(r0 + i) * PD + 8 * cg, s0 * inv - a, s1 * inv - b);
            if (t - w + 1 >= 0) { f32x4 c, d; ld_bf16x8(ZP + (size_t)(r0 + i - w + 1) * PD + 8 * cg, c, d); s0 -= c; s1 -= d; } }
    }
}

typedef float hg_f32x2 __attribute__((ext_vector_type(2)));
constexpr int HG_IMG_BYTES = 34816, HG_IQP = 0, HG_IKP = 17408, HG_IMG_LDS = 36864;
constexpr int HG_VEC = 384;
constexpr int HG_U_BYTES = 32768;
constexpr int HG_TOT = 0, HP_BUF = 8192, HP_KP = 0, HP_V = 17408, HP_CD = 34816, HP_STRIDE = 36864;
constexpr int HO_IMG = 0, HO_ST = HG_IMG_LDS, HO_V = 2 * HG_IMG_LDS, HO_PS = HO_V + 17408, HO_SS = HO_PS + 9216, HO_END = HO_SS + 512;
static_assert(HP_BUF + 2 * HP_STRIDE <= LDSCTL_OFF && HO_END <= LDSCTL_OFF, "hgrn LDS maps");
#define HG_BAR() do { asm volatile("s_waitcnt lgkmcnt(0)" ::: "memory"); __builtin_amdgcn_s_barrier(); asm volatile("" ::: "memory"); } while (0)
typedef short hg_s16x4 __attribute__((ext_vector_type(4)));
__device__ __forceinline__ bf16x8 hgs_kpt(LAS unsigned char* KP, int j, int ks, int lane) {
    const int g = lane >> 4, q = (lane & 15) >> 2, p = lane & 3;
    LAS unsigned char* a0 = KP + (32 * ks + 8 * g + q) * 272 + (16 * j + 4 * p) * 2;
    const hg_s16x4 lo = __builtin_amdgcn_ds_read_tr16_b64_v4i16((LAS hg_s16x4*)a0), hi = __builtin_amdgcn_ds_read_tr16_b64_v4i16((LAS hg_s16x4*)(a0 + 4 * 272));
    bf16x8 r; r[0] = lo[0]; r[1] = lo[1]; r[2] = lo[2]; r[3] = lo[3]; r[4] = hi[0]; r[5] = hi[1]; r[6] = hi[2]; r[7] = hi[3]; return r;
}
__device__ __forceinline__ void hgp_load(const float* G, const bf16_t* Q, const bf16_t* KK, const bf16_t* V, int unit, int wave, int lane, hg_f32x2 (&g)[8], unsigned (&q2)[8], unsigned (&k2)[8], u32x4 (&v4)[2]) {
    const int b = unit >> 8, h = (unit >> 5) & 7, c = unit & 31;
    const size_t rb = (size_t)b * SEQ + (size_t)c * 64, colb = (size_t)h * 128 + 2 * lane;
#pragma unroll
    for (int i = 0; i < 8; ++i) { const size_t o = (rb + 8 * wave + i) * HDIM + colb; g[i] = *(const hg_f32x2*)(G + o); q2[i] = *(const unsigned*)(Q + o); k2[i] = *(const unsigned*)(KK + o); }
    const int tid = wave * 64 + lane; const bf16_t* vp = V + (rb + (tid >> 3)) * HDIM + h * 128 + 16 * (tid & 7);
    v4[0] = *(const u32x4*)vp; v4[1] = *(const u32x4*)(vp + 8);
}
__device__ __forceinline__ void hgp_unit(unsigned char* IMG, float* VEC, unsigned char* UB, LAS unsigned char* L, int unit, int par, int wave, int lane, const hg_f32x2 (&g)[8], const unsigned (&q2)[8], const unsigned (&k2)[8], const u32x4 (&v4)[2]) {
    hg_f32x2 p[8]; p[0] = g[0];
#pragma unroll
    for (int i = 1; i < 8; ++i) p[i] = p[i - 1] + g[i];
    LAS unsigned char* T = L + HG_TOT + par * 4096;
    LAS unsigned char* KPL = L + HP_BUF + par * HP_STRIDE + HP_KP; LAS unsigned char* VL = L + HP_BUF + par * HP_STRIDE + HP_V; LAS float* CDL = (LAS float*)(L + HP_BUF + par * HP_STRIDE + HP_CD);
    *(LAS hg_f32x2*)(T + (wave * 128 + 2 * lane) * 4) = p[7];
    { const int tid = wave * 64 + lane; LAS unsigned char* vd = VL + (tid >> 3) * 272 + (tid & 7) * 32; *(LAS u32x4*)vd = v4[0]; *(LAS u32x4*)(vd + 16) = v4[1]; }
    HG_BAR();
    hg_f32x2 offs = {0.f, 0.f}, bmid = {0.f, 0.f}, bl = {0.f, 0.f};
#pragma unroll
    for (int s = 0; s < 8; ++s) { const hg_f32x2 ts = *(const LAS hg_f32x2*)(T + (s * 128 + 2 * lane) * 4); if (s < wave) offs += ts; if (s < 4) bmid += ts; bl += ts; }
    unsigned char* img = IMG + (size_t)unit * HG_IMG_BYTES;
#pragma unroll
    for (int i = 0; i < 8; ++i) { const int t = 8 * wave + i; const hg_f32x2 x = offs + p[i] - bmid;
        const float qa = bf_lo(q2[i]), qb = bf_hi(q2[i]), ka = bf_lo(k2[i]), kb = bf_hi(k2[i]);
        const float ep0 = ex2(fminf(x.x, 126.f)), ep1 = ex2(fminf(x.y, 126.f)), ek0 = ex2(fminf(-x.x, 126.f)), ek1 = ex2(fminf(-x.y, 126.f));
        *(unsigned*)(img + HG_IQP + t * 272 + lane * 4) = cvt_pk_bf16(qa * ep0, qb * ep1);
        const unsigned kw = cvt_pk_bf16(ka * ek0, kb * ek1);
        *(unsigned*)(img + HG_IKP + t * 272 + lane * 4) = kw; *(LAS unsigned*)(KPL + t * 272 + lane * 4) = kw; }
    if (wave == 0) { float* v = VEC + (size_t)unit * HG_VEC + 2 * lane;
        hg_f32x2 d; d.x = ex2(bl.x); d.y = ex2(bl.y); *(hg_f32x2*)v = d;
        hg_f32x2 ci; ci.x = ex2(bmid.x); ci.y = ex2(bmid.y); *(hg_f32x2*)(v + 128) = ci;
        hg_f32x2 cd; cd.x = ex2(bl.x - bmid.x); cd.y = ex2(bl.y - bmid.y); *(hg_f32x2*)(v + 256) = cd; *(LAS hg_f32x2*)(CDL + 2 * lane) = cd; }
    HG_BAR();
    { const int lr = lane & 15, lq = lane >> 4;
      f32x4 u[8];
#pragma unroll
      for (int vt = 0; vt < 8; ++vt) u[vt] = (f32x4){0.f, 0.f, 0.f, 0.f};
#pragma unroll
      for (int ks = 0; ks < 2; ++ks) { const bf16x8 A = hgs_kpt(KPL, wave, ks, lane);
#pragma unroll
          for (int vt = 0; vt < 8; ++vt) { const bf16x8 B = hgs_kpt(VL, vt, ks, lane); u[vt] = __builtin_amdgcn_mfma_f32_16x16x32_bf16(A, B, u[vt], 0, 0, 0); } }
      const f32x4 cdv = *(const LAS f32x4*)(CDL + 16 * wave + 4 * lq);
      unsigned char* ub = UB + (size_t)unit * HG_U_BYTES + (size_t)(lr * 128 + 16 * wave + 4 * lq) * 2;
#pragma unroll
      for (int vt = 0; vt < 8; ++vt) { const f32x4 s = u[vt] * cdv; u32x2 w; w.x = cvt_pk_bf16(s[0], s[1]); w.y = cvt_pk_bf16(s[2], s[3]); *(u32x2*)(ub + vt * 16 * 256) = w; } }
}
__device__ __forceinline__ void p_hgrn_pre(Frame& F) {
    PHASE_IDS();
    const bf16_t* Q = (const bf16_t*)(F.ws + oq(WS_Q)); const bf16_t* KK = (const bf16_t*)(F.ws + oq(WS_KK)); const float* G = (const float*)(F.ws + oq(WS_G)); const bf16_t* V = (const bf16_t*)(F.ws + oq(WS_V));
    unsigned char* IMG = F.ws + oq(WS_HIMG); float* VEC = (float*)(F.ws + oq(WS_HVEC)); unsigned char* UB = F.ws + oq(WS_HU);
    hg_f32x2 ga[8], gb[8]; unsigned qa[8], qb[8], ka[8], kb[8]; u32x4 va[2], vb[2];
    int u = blockIdx.x;
    if (u < 1024) hgp_load(G, Q, KK, V, u, wave, lane, ga, qa, ka, va);
    while (u < 1024) {
        const int u2 = u + F.G;
        if (u2 < 1024) hgp_load(G, Q, KK, V, u2, wave, lane, gb, qb, kb, vb);
        hgp_unit(IMG, VEC, UB, F.lds, u, 0, wave, lane, ga, qa, ka, va);
        if (u2 >= 1024) break;
        const int u3 = u2 + F.G;
        if (u3 < 1024) hgp_load(G, Q, KK, V, u3, wave, lane, ga, qa, ka, va);
        hgp_unit(IMG, VEC, UB, F.lds, u2, 1, wave, lane, gb, qb, kb, vb);
        u = u3;
    }
    HG_BAR();
}
__device__ __forceinline__ void p_hgrn_state(Frame& F) {
    PHASE_IDS();
    const unsigned char* UB = F.ws + oq(WS_HU); const float* VEC = (const float*)(F.ws + oq(WS_HVEC)); unsigned char* STI = F.ws + oq(WS_HST);
    for (int gid = (int)blockIdx.x * 512 + tid; gid < 32 * 4096; gid += F.G * 512) {
        const int bh = gid >> 12, e = gid & 4095, vcol = e >> 5, ch0 = (e & 31) * 4;
        const unsigned char* up = UB + (size_t)bh * 32 * HG_U_BYTES + (size_t)(vcol * 128 + ch0) * 2;
        const float* vp = VEC + (size_t)bh * 32 * HG_VEC + ch0;
        unsigned char* sp = STI + (size_t)bh * 32 * HG_IMG_BYTES + (size_t)vcol * 272 + ch0 * 2;
        f32x4 st = {0.f, 0.f, 0.f, 0.f};
        for (int c0 = 0; c0 < 32; c0 += 8) {
            u32x2 uu[8]; f32x4 dd[8], ci[8];
#pragma unroll
            for (int k = 0; k < 8; ++k) { uu[k] = *(const u32x2*)(up + (size_t)(c0 + k) * HG_U_BYTES); dd[k] = *(const f32x4*)(vp + (size_t)(c0 + k) * HG_VEC); ci[k] = *(const f32x4*)(vp + (size_t)(c0 + k) * HG_VEC + 128); }
#pragma unroll
            for (int k = 0; k < 8; ++k) { const f32x4 s = st * ci[k]; u32x2 w; w.x = cvt_pk_bf16(s[0], s[1]); w.y = cvt_pk_bf16(s[2], s[3]); *(u32x2*)(sp + (size_t)(c0 + k) * HG_IMG_BYTES) = w;
                const f32x4 uf = {bf_lo(uu[k].x), bf_hi(uu[k].x), bf_lo(uu[k].y), bf_hi(uu[k].y)}; st = st * dd[k] + uf; }
        }
    }
}
__device__ __forceinline__ void hgo_dma9(const char* src, unsigned dst) {
#pragma unroll
    for (int i = 0; i < 9; ++i) { unsigned keep; const char* g = src + i * 4096; const unsigned d = dst + (unsigned)i * 4096u;
        asm volatile("s_mov_b32 %0, m0\n\ts_mov_b32 m0, %2\n\ts_nop 0\n\tglobal_load_lds_dwordx4 %1, off\n\ts_mov_b32 m0, %0" : "=&s"(keep) : "v"(g), "s"(d) : "memory"); }
}
__device__ __forceinline__ void p_hgrn_out(Frame& F, int layer, int part, int nparts) {
    PHASE_IDS();
    LAS unsigned char* L = F.lds; const int lr = lane & 15, lq = lane >> 4;
    const unsigned char* IMG = F.ws + oq(WS_HIMG); const unsigned char* STI = F.ws + oq(WS_HST); const bf16_t* V = (const bf16_t*)(F.ws + oq(WS_V)); const bf16_t* OG = (const bf16_t*)(F.ws + oq(WS_OG));
    const float* gain = g_(F.in[6]) + layer * HDIM; bf16_t* AB = (bf16_t*)(F.ws + oq(WS_AB));
    for (int i = tid; i < 9216 / 4; i += 512) ((LAS unsigned*)(L + HO_PS))[i] = 0u;
    const int wq = wave & 3;
    const unsigned dst = (unsigned)__builtin_amdgcn_readfirstlane((int)(unsigned)(size_t)(L + (wave < 4 ? HO_IMG : HO_ST) + wq * 1024));
    const int tt_o = wave >> 1, jh = wave & 1;
    for (int unit = part; unit < 1024; unit += nparts) {
        const int b = unit >> 8, h = (unit >> 5) & 7, c = unit & 31; const size_t rb = (size_t)b * SEQ + (size_t)c * 64;
        { const bf16_t* vp = V + (rb + (tid >> 3)) * HDIM + h * 128 + 16 * (tid & 7); const u32x4 v0 = *(const u32x4*)vp, v1 = *(const u32x4*)(vp + 8);
          hgo_dma9((const char*)(wave < 4 ? IMG : STI) + (size_t)unit * HG_IMG_BYTES + (size_t)wq * 1024 + (unsigned)lane * 16u, dst);
          LAS unsigned char* vd = L + HO_V + (tid >> 3) * 272 + (tid & 7) * 32; *(LAS u32x4*)vd = v0; *(LAS u32x4*)(vd + 16) = v1; }
        asm volatile("s_waitcnt vmcnt(0)" ::: "memory");
        HG_BAR();
        u32x2 og[4]; f32x4 gn[4];
#pragma unroll
        for (int j = 0; j < 4; ++j) { const int col = h * 128 + 16 * (4 * jh + j) + 4 * lq; og[j] = *(const u32x2*)(OG + (rb + 16 * tt_o + lr) * HDIM + col); gn[j] = *(const f32x4*)(gain + col); }
#pragma unroll
        for (int k = 0; k < 2; ++k) { const int idx = wave + 8 * k;
            if (idx < 10) { const int tt = idx >= 6 ? 3 : (idx >= 3 ? 2 : (idx >= 1 ? 1 : 0)), sx = idx - ((tt * (tt + 1)) >> 1);
                f32x4 a = {0.f, 0.f, 0.f, 0.f};
#pragma unroll
                for (int ks = 0; ks < 4; ++ks) { const bf16x8 A = *(const LAS bf16x8*)(L + HO_IMG + HG_IKP + (16 * sx + lr) * 272 + (32 * ks + 8 * lq) * 2), B = *(const LAS bf16x8*)(L + HO_IMG + HG_IQP + (16 * tt + lr) * 272 + (32 * ks + 8 * lq) * 2);
                    a = __builtin_amdgcn_mfma_f32_16x16x32_bf16(A, B, a, 0, 0, 0); }
                if (sx == tt) {
#pragma unroll
                    for (int r = 0; r < 4; ++r) if (4 * lq + r > lr) a[r] = 0.f; }
                u32x2 w; w.x = cvt_pk_bf16(a[0], a[1]); w.y = cvt_pk_bf16(a[2], a[3]);
                *(LAS u32x2*)(L + HO_PS + (16 * tt + lr) * 144 + (16 * sx + 4 * lq) * 2) = w; } }
        HG_BAR();
        f32x4 o[4];
#pragma unroll
        for (int j = 0; j < 4; ++j) { f32x4 a = {0.f, 0.f, 0.f, 0.f};
#pragma unroll
            for (int ks = 0; ks < 2; ++ks) { const bf16x8 A = hgs_kpt(L + HO_V, 4 * jh + j, ks, lane), B = *(const LAS bf16x8*)(L + HO_PS + (16 * tt_o + lr) * 144 + (32 * ks + 8 * lq) * 2);
                a = __builtin_amdgcn_mfma_f32_16x16x32_bf16(A, B, a, 0, 0, 0); }
#pragma unroll
            for (int ks = 0; ks < 4; ++ks) { const bf16x8 A = *(const LAS bf16x8*)(L + HO_ST + (16 * (4 * jh + j) + lr) * 272 + (32 * ks + 8 * lq) * 2), B = *(const LAS bf16x8*)(L + HO_IMG + HG_IQP + (16 * tt_o + lr) * 272 + (32 * ks + 8 * lq) * 2);
                a = __builtin_amdgcn_mfma_f32_16x16x32_bf16(A, B, a, 0, 0, 0); }
            o[j] = a; }
        float ss = 0.f;
#pragma unroll
        for (int j = 0; j < 4; ++j) ss += (o[j][0] * o[j][0] + o[j][1] * o[j][1]) + (o[j][2] * o[j][2] + o[j][3] * o[j][3]);
        ss += __shfl_xor(ss, 16); ss += __shfl_xor(ss, 32);
        LAS float* SSX = (LAS float*)(L + HO_SS);
        if (lq == 0) SSX[wave * 16 + lr] = ss;
        HG_BAR();
        ss += SSX[(wave ^ 1) * 16 + lr];
        const float rstd = __builtin_amdgcn_rsqf(ss * (1.0f / 128.0f) + EPS);
        bf16_t* ob = AB + (rb + 16 * tt_o + lr) * DM + PD + h * 128 + 16 * (4 * jh) + 4 * lq;
#pragma unroll
        for (int j = 0; j < 4; ++j) { const f32x4 g4 = {bf_lo(og[j].x), bf_hi(og[j].x), bf_lo(og[j].y), bf_hi(og[j].y)}; const f32x4 r = o[j] * rstd * gn[j] * g4;
            u32x2 w; w.x = cvt_pk_bf16(r[0], r[1]); w.y = cvt_pk_bf16(r[2], r[3]); *(u32x2*)(ob + 16 * j) = w; }
    }
    HG_BAR();
}
#undef HG_BAR
__device__ __forceinline__ void p_final(Frame& F) {
    PHASE_IDS();
    const bf16_t* HB = (const bf16_t*)(F.ws + oq(WS_HB)); const float* SS = (const float*)(F.ws + oq(WS_SS)); const float* nf = g_(F.in[19]);
    const int gw = F.vcu * NWAVES + wave, NGW = F.G * NWAVES;
    for (int m = gw; m < MROWS; m += NGW) {
        float s = 0.f;
#pragma unroll
        for (int j = 0; j < 8; ++j) s += SS[(size_t)j * MROWS + m];
        const float rstd = __builtin_amdgcn_rsqf(s * (1.0f / DM) + EPS);
        const u32x4* hr = (const u32x4*)(HB + (size_t)m * DM) + lane; f32x4* orow = (f32x4*)(g_(F.out) + (size_t)m * DM) + 2 * lane; const f32x4* g4 = (const f32x4*)nf + 2 * lane;
#pragma unroll
        for (int j = 0; j < 4; ++j) { const u32x4 w = hr[64 * j];
            orow[128 * j] = (f32x4){bf_lo(w.x), bf_hi(w.x), bf_lo(w.y), bf_hi(w.y)} * rstd * g4[128 * j];
            orow[128 * j + 1] = (f32x4){bf_lo(w.z), bf_hi(w.z), bf_lo(w.w), bf_hi(w.w)} * rstd * g4[128 * j + 1]; }
    }
}

constexpr int PH_PRO = 0, PH_KV = 1, PH_MQ = 2, PH_L0 = 3, PH_PER_LAYER = 10, PH_FINAL = PH_L0 + DEPTH * PH_PER_LAYER, N_PHASES = PH_FINAL + 1;
struct Args { const float* in[20]; float* out; unsigned char* ws; int lo, hi; };
__global__ void __launch_bounds__(NWAVES * 64, 2) mk_fwd(Args args) {
    extern __shared__ __attribute__((aligned(16))) unsigned char lds_raw[];
    Frame F;
    F.lds = (LAS unsigned char*)lds_raw;
    F.G = gridDim.x; { const int bx = blockIdx.x; F.vcu = (F.G % 8 == 0) ? (bx % 8) * (F.G / 8) + bx / 8 : bx; }
    F.in = args.in; F.out = args.out; F.ws = args.ws;
    unsigned char* ws = g_(args.ws);
    for (int u = threadIdx.x; u < (LDS_BYTES - LDSCTL_OFF) / 4; u += NWAVES * 64) ((LAS unsigned*)(F.lds + LDSCTL_OFF))[u] = 0u;
    __syncthreads();
    const int lo = args.lo, hi = args.hi;
    unsigned* barw = (unsigned*)(ws + WS_CTL) + CW_BAR;
    XcdBarrier bar; bar.bar = barw; bar.x = 0; bar.st = (volatile LAS unsigned*)(F.lds + MISC_OFF) + 8;
    if (hi - lo > 1) bar = xcd_barrier_post(barw, (volatile LAS unsigned*)(F.lds + MISC_OFF) + 8);
#ifndef PHMASK
#define PHMASK 0xFFFFF
#endif
#define EN(j) (((PHMASK) >> (j)) & 1)
#define IN(k) (lo <= (k) && (k) < hi)
#define SEAM(k) do { if (IN(k) && IN((k) + 1)) xcd_barrier(bar); } while (0)
    const int G = F.G, c0 = (int)blockIdx.x;
    LAS unsigned char* ring = F.lds;

    if (EN(0) && IN(PH_PRO)) { p_prologue(F); } SEAM(PH_PRO);

    if (EN(1) && IN(PH_KV)) {
        pg8::Gemm g{(const bf16_t*)(ws + WS_MEMB), (const bf16_t*)(ws + WS_WK), DM, DM, DM}; pg8::Sched S; S.init_plain(MEMROWS / 256, 2 * DEPTH * DM / 256, G, c0, DM, DM);
        pg8::EpiRowScale E{(bf16_t*)(ws + WS_KVB), 2 * DEPTH * DM, nullptr, (const float*)(ws + WS_RSM), 1.0f};
        pg8::gemm_phase<pg8::EpiRowScale>(ring, g, S, E);
    } SEAM(PH_KV);

#define FOLD_MQ(ll, cc, GG) do { unsigned char* w_ = ws + oq(0); pg8::Gemm g{(const bf16_t*)(w_ + WS_KVB) + (size_t)(ll) * DM, (const bf16_t*)(w_ + WS_WL + (size_t)(ll) * WL_SIZE + WL_WXQ), 2 * DEPTH * DM, DM, XHD}; \
        pg8::Sched S; S.init(NB * XH, DM / 256, (GG), (cc), 0, 0, 0, 0, 0, 0); S.mode = 1; \
        pg8::EpiColScale E{(bf16_t*)(w_ + WS_MQ) + (size_t)(ll) * NB * XH * MEML * DM, DM, nullptr}; pg8::gemm_phase<pg8::EpiColScale>(ring, g, S, E); } while (0)
#define FOLD_VW(ll, cc, GG) do { unsigned char* w_ = ws + oq(0); pg8::Gemm g{(const bf16_t*)(w_ + WS_WL + (size_t)(ll) * WL_SIZE + WL_WXO), (const bf16_t*)(w_ + WS_KVB) + (size_t)DEPTH * DM + (size_t)(ll) * DM, DM, 2 * DEPTH * DM, XHD}; \
        pg8::Sched S; S.init(NB * DM / 256, XH, (GG), (cc), 0, 0, 0, 0, 0, 0); S.mode = 2; \
        pg8::EpiColScale E{(bf16_t*)(w_ + WS_VW) + (size_t)(ll) * NB * DM * XH * MEML, XH * MEML, nullptr}; pg8::gemm_phase<pg8::EpiColScale>(ring, g, S, E); } while (0)

    if (EN(2) && IN(PH_MQ)) {
        if (c0 < G / 2) FOLD_MQ(0, c0, G / 2); else FOLD_VW(0, c0 - G / 2, G - G / 2);
    } SEAM(PH_MQ);

    for (int l = 0; l < DEPTH; ++l) {
        const int pb = PH_L0 + l * PH_PER_LAYER;
        unsigned char* wl = ws + oq(WS_WL) + (size_t)l * WL_SIZE;
        if (EN(3) && IN(pb + 0)) {
            pg8::Gemm g{(const bf16_t*)(ws + oq(WS_HB)), (const bf16_t*)(wl + WL_WIN), DM, DM, DM}; pg8::Sched S; S.init_plain(MROWS / 256, INC / 256, G, c0, DM, DM);
            pg8::EpiZ E{(bf16_t*)(ws + oq(WS_ZP)), (bf16_t*)(ws + oq(WS_Q)), (bf16_t*)(ws + oq(WS_KK)), (bf16_t*)(ws + oq(WS_V)), (bf16_t*)(ws + oq(WS_OG)), (bf16_t*)(ws + oq(WS_GA)), (bf16_t*)(ws + oq(WS_GB)),
                        (float*)(ws + oq(WS_G)), (const float*)(ws + oq(WS_SS)), (const float*)(ws + oq(WS_LB)) + l * HDIM};
            S.i1 = 4;
            pg8::gemm_phase<pg8::EpiZ>(ring, g, S, E);
        } SEAM(pb + 0);
        if (EN(4) && IN(pb + 1)) { p_pool(F); p_hgrn_pre(F); } SEAM(pb + 1);
        if (EN(5) && IN(pb + 2)) { p_hgrn_state(F); } SEAM(pb + 2);
        if (EN(6) && IN(pb + 3)) {
            if (c0 < G / 2) {
                pg8::Gemm g{(const bf16_t*)(ws + oq(WS_POOLED)), (const bf16_t*)(wl + WL_WG), PD, 256, 256}; pg8::Sched S;
                S.init(MROWS / 256, 4, G / 2, c0, (long)256 * PD * 2, 256 * 2, 0, 0, 0, (long)256 * 256 * 2);
                pg8::EpiColScale E{(bf16_t*)(ws + oq(WS_AB)), DM, g_(F.in[4]) + l * PD};
                pg8::gemm_phase<pg8::EpiColScale>(ring, g, S, E);
                {
                    pg8::Gemm g2{(const bf16_t*)(ws + oq(WS_HB)), (const bf16_t*)(wl + WL_WIN), DM, DM, DM}; pg8::Sched S2; S2.init_plain(MROWS / 256, INC / 256, G, c0, DM, DM); S2.i0 = 4;
                    pg8::EpiZ E2{(bf16_t*)(ws + oq(WS_ZP)), (bf16_t*)(ws + oq(WS_Q)), (bf16_t*)(ws + oq(WS_KK)), (bf16_t*)(ws + oq(WS_V)), (bf16_t*)(ws + oq(WS_OG)), (bf16_t*)(ws + oq(WS_GA)), (bf16_t*)(ws + oq(WS_GB)),
                                 (float*)(ws + oq(WS_G)), (const float*)(ws + oq(WS_SS)), (const float*)(ws + oq(WS_LB)) + l * HDIM};
                    pg8::gemm_phase<pg8::EpiZ>(ring, g2, S2, E2); }
            } else {
                p_hgrn_out(F, l, c0 - G / 2, G - G / 2);
                if (l == 0) p_cvt_slot(F, 0, CV_L0_LATE_LO, CV_L0_LATE_HI - CV_L0_LATE_LO, c0 - G / 2, G - G / 2);
                if (l + 1 < DEPTH) p_cvt_slot(F, l + 1, 0, CV_N1, c0 - G / 2, G - G / 2); }
        } SEAM(pb + 3);
        if (EN(7) && IN(pb + 4)) {
            pg8::Gemm g{(const bf16_t*)(ws + oq(WS_AB)), (const bf16_t*)(wl + WL_WBR), DM, DM, DM}; pg8::Sched S; S.init_plain(MROWS / 256, DM / 256, G, c0, DM, DM);
            pg8::EpiBranch E{(bf16_t*)(ws + oq(WS_MERGED)), (const bf16_t*)(ws + oq(WS_GA)), (const bf16_t*)(ws + oq(WS_GB))};
            pg8::gemm_phase<pg8::EpiBranch>(ring, g, S, E);
        } SEAM(pb + 4);
        if (EN(8) && IN(pb + 5)) {
            pg8::Gemm g{(const bf16_t*)(ws + oq(WS_MERGED)), (const bf16_t*)(wl + WL_WMIX), DM, DM, DM}; pg8::Sched S; S.init_plain(MROWS / 256, DM / 256, G, c0, DM, DM);
            pg8::EpiRes E{(bf16_t*)(ws + oq(WS_HB)), (float*)(ws + oq(WS_SS))};
            pg8::gemm_phase<pg8::EpiRes, false>(ring, g, S, E);
        } SEAM(pb + 5);
        if (EN(9) && IN(pb + 6)) {
            pg8::Gemm g{(const bf16_t*)(ws + oq(WS_HB)), (const bf16_t*)(ws + oq(WS_MQ)) + (size_t)l * NB * XH * MEML * DM, DM, DM, DM}; pg8::Sched S;
            S.init(MROWS / 256, XH, G, c0, (long)256 * DM * 2, 0, 0, (long)XH * MEML * DM * 2, 3, (long)MEML * DM * 2);
            pg8::EpiSoftmax E{(bf16_t*)(ws + oq(WS_P)), XH * MEML, (const float*)(ws + oq(WS_SS)), 0.044194173824159216f};
            pg8::gemm_phase<pg8::EpiSoftmax, false>(ring, g, S, E);
            if (l + 1 < DEPTH && c0 >= G / 2) {
                FOLD_MQ(l + 1, c0 - G / 2, G - G / 2); FOLD_VW(l + 1, c0 - G / 2, G - G / 2);
                p_cvt_slot(F, l + 1, CV_N1, CV_N3, c0 - G / 2, G - G / 2); }
        } SEAM(pb + 6);
        if (EN(10) && IN(pb + 7)) {
            pg8::Gemm g{(const bf16_t*)(ws + oq(WS_P)), (const bf16_t*)(ws + oq(WS_VW)) + (size_t)l * NB * DM * XH * MEML, XH * MEML, XH * MEML, XH * MEML}; pg8::Sched S;
            S.init(MROWS / 256, DM / 256, G, c0, (long)256 * XH * MEML * 2, 0, 0, (long)DM * XH * MEML * 2, 3, (long)256 * XH * MEML * 2);
            pg8::EpiRes E{(bf16_t*)(ws + oq(WS_HB)), (float*)(ws + oq(WS_SS))};
            pg8::gemm_phase<pg8::EpiRes, false>(ring, g, S, E);
        } SEAM(pb + 7);
        if (EN(11) && IN(pb + 8)) {
            pg8::Gemm g{(const bf16_t*)(ws + oq(WS_HB)), (const bf16_t*)(wl + WL_WFI), DM, DM, DM}; pg8::Sched S; S.init_plain(MROWS / 256, 2 * DFF / 256, G, c0, DM, DM);
            pg8::EpiFfn E{(bf16_t*)(ws + oq(WS_ACT)), (const float*)(ws + oq(WS_SS))};
            pg8::gemm_phase<pg8::EpiFfn>(ring, g, S, E);
            if (l + 1 < DEPTH && c0 >= G / 2) p_cvt_slot(F, l + 1, CV_N1 + CV_N3, CV_N2, c0 - G / 2, G - G / 2);
        } SEAM(pb + 8);
        if (EN(12) && IN(pb + 9)) {
            pg8::Gemm g{(const bf16_t*)(ws + oq(WS_ACT)), (const bf16_t*)(wl + WL_WFO), DFF, DFF, DFF}; pg8::Sched S; S.init_plain(MROWS / 256, DM / 256, G, c0, DFF, DFF);
            pg8::EpiRes E{(bf16_t*)(ws + oq(WS_HB)), (float*)(ws + oq(WS_SS))};
            pg8::gemm_phase<pg8::EpiRes, false>(ring, g, S, E);
        } SEAM(pb + 9);
    }
    if (EN(13) && IN(PH_FINAL)) { p_final(F); }
#ifdef PROBE_X
    if (IN(N_PHASES + 0)) { p_pool(F); }
    if (IN(N_PHASES + 1)) { p_hgrn_state(F); }
    if (IN(N_PHASES + 3)) { p_hgrn_pre(F); }
    if (IN(N_PHASES + 4)) { if (c0 >= G / 2) p_cvt_slot(F, 1, 0, 8192, c0 - G / 2, G - G / 2); }
    if (IN(N_PHASES + 5)) { p_cvt_slot(F, 1, 0, 16384, c0, G); }
    if (IN(N_PHASES + 2)) {
        pg8::Gemm g{(const bf16_t*)(ws + oq(WS_HB)), (const bf16_t*)(ws + oq(WS_WL) + WL_WIN), DM, DM, DM}; pg8::Sched S; S.init_plain(MROWS / 256, INC / 256, G, c0, DM, DM);
        pg8::EpiColScale E{(bf16_t*)(ws + oq(WS_ZP)), INC, nullptr}; pg8::gemm_phase<pg8::EpiColScale>(ring, g, S, E); }
#endif
#undef FOLD_MQ
#undef FOLD_VW
#undef IN
#undef SEAM
}

extern "C" void kernel_launch(void* const* d_in, const int* in_sizes, int n_in, void* d_out, int out_size, void* d_ws, size_t ws_size, hipStream_t stream) {
    static int grid = 0;
    if (grid == 0) {
        if (n_in != 20 || out_size != MROWS * DM || ws_size < WS_END) { fprintf(stderr, "kernel_launch: unexpected problem (n_in %d, out %d, ws %zu < %zu)\n", n_in, out_size, ws_size, (size_t)WS_END); grid = -1; return; }
        if (hipFuncSetAttribute((const void*)mk_fwd, hipFuncAttributeMaxDynamicSharedMemorySize, LDS_BYTES) != hipSuccess) { fprintf(stderr, "kernel_launch: hipFuncSetAttribute failed\n"); grid = -1; return; }
        int per_cu = 0;
        if (hipOccupancyMaxActiveBlocksPerMultiprocessor(&per_cu, (const void*)mk_fwd, NWAVES * 64, LDS_BYTES) != hipSuccess || per_cu < 1) fprintf(stderr, "kernel_launch: occupancy query reports %d\n", per_cu);
        (void)hipGetLastError();
        grid = 256;
    }
    if (grid < 0) return;
    (void)hipMemsetAsync((char*)d_ws + WS_CTL, 0, CTL_ZERO_BYTES, stream);
    Args a{};
    for (int i = 0; i < 20; ++i) a.in[i] = (const float*)d_in[i];
    a.out = (float*)d_out; a.ws = (unsigned char*)d_ws;
#if MK_PER_PHASE
    for (int p = 0; p < N_PHASES; ++p) { a.lo = p; a.hi = p + 1; hipLaunchKernelGGL(mk_fwd, dim3(grid), dim3(NWAVES * 64), LDS_BYTES, stream, a); }
#else
    a.lo = 0; a.hi = N_PHASES; hipLaunchKernelGGL(mk_fwd, dim3(grid), dim3(NWAVES * 64), LDS_BYTES, stream, a);
#endif
#ifdef PROBE_X
    for (int l = 0; l < DEPTH; ++l) { const int p = (PROBE_X < 0) ? (-PROBE_X - 1) : (PROBE_X >= 200 ? PH_L0 + 3 * PH_PER_LAYER + PROBE_X - 200 : (PROBE_X >= 100 ? N_PHASES + PROBE_X - 100 : PH_L0 + l * PH_PER_LAYER + PROBE_X)); a.lo = p; a.hi = p + 1;
        hipLaunchKernelGGL(mk_fwd, dim3(grid), dim3(NWAVES * 64), LDS_BYTES, stream, a); }
#endif
}
```
